# Optimizing an MI355X kernel written in HIP

```python
import math
import jax, jax.numpy as jnp
from jax import lax
import numpy as np

D_MODEL = 1024
BATCH = 1
SEQ = 16384
DEPTH = 1
DEC_BATCH = 8
DEC_SEQ = 32
PAST_LEN = 1024

CHUNK = 64
BAND_PREV = 8
BAND = (BAND_PREV + 1) * CHUNK
REL_CLIP = 128
H_A = 8
HD_A = 64
H_B = 4
HD_B = 64
ROT_DIM = HD_B // 4
ROPE_THETA = 500000.0
N_MEM = 256
H_M = 4
HD_M = D_MODEL // H_M
D_FF = 2816
CONV_W = 3
Q_BLOCK = 128
LN_EPS = 1e-5
DEEPNORM_ALPHA = (2.0 * DEPTH) ** 0.25
DEEPNORM_BETA = (8.0 * DEPTH) ** -0.25
A_WIDTH = H_A * HD_A
B_WIDTH = H_B * 2 * HD_B
MIX_WIDTH = A_WIDTH + B_WIDTH
QKV_DIM = 3 * A_WIDTH + 3 * B_WIDTH

kernel_name = "hybrid_chunkband_diffattn_stream_step"


def layer_norm(x, g, b):
    xf = x.astype(jnp.float32)
    mu = jnp.mean(xf, -1, keepdims=True)
    var = jnp.mean(jnp.square(xf - mu), -1, keepdims=True)
    return ((xf - mu) * lax.rsqrt(var + LN_EPS) * g.astype(jnp.float32) + b.astype(jnp.float32)).astype(x.dtype)


def partial_rope(x, pos):
    half = ROT_DIM // 2
    inv = ROPE_THETA ** (-jnp.arange(0, ROT_DIM, 2, dtype=jnp.float32) / ROT_DIM)
    ang = pos.astype(jnp.float32)[:, None] * inv[None, :]
    shp = (1, pos.shape[0]) + (1,) * (x.ndim - 3) + (half,)
    cos, sin = jnp.cos(ang).reshape(shp), jnp.sin(ang).reshape(shp)
    xr = x[..., :ROT_DIM].astype(jnp.float32)
    x1, x2 = xr[..., :half], xr[..., half:]
    rot = jnp.concatenate([x1 * cos - x2 * sin, x2 * cos + x1 * sin], -1)
    return jnp.concatenate([rot.astype(x.dtype), x[..., ROT_DIM:]], -1)


def project_groups(h, w_qkv, pos):
    B, S, _ = h.shape
    z = h @ w_qkv
    qa, ka, va, qb, kb, vb = jnp.split(z, [A_WIDTH, 2 * A_WIDTH, 3 * A_WIDTH, 3 * A_WIDTH + B_WIDTH, 3 * A_WIDTH + 2 * B_WIDTH], axis=-1)
    qa = qa.reshape(B, S, H_A, HD_A)
    ka = ka.reshape(B, S, H_A, HD_A)
    va = va.reshape(B, S, H_A, HD_A)
    qb = partial_rope(qb.reshape(B, S, H_B, 2, HD_B), pos)
    kb = partial_rope(kb.reshape(B, S, H_B, 2, HD_B), pos)
    vb = vb.reshape(B, S, H_B, 2 * HD_B)
    return qa, ka, va, qb, kb, vb


def rel_bias_lookup(rel_bias, rel):
    return rel_bias[:, jnp.clip(rel, -REL_CLIP, REL_CLIP) + REL_CLIP].astype(jnp.float32)


def chunk_band_attn_prompt(q, k, v, rel_bias):
    B, S, H, D = q.shape
    nc = S // CHUNK
    qc = q.reshape(B, nc, CHUNK, H, D)
    pad = ((0, 0), (BAND_PREV * CHUNK, 0), (0, 0), (0, 0))
    kp = jnp.pad(k, pad).reshape(B, nc + BAND_PREV, CHUNK, H, D)
    vp = jnp.pad(v, pad).reshape(B, nc + BAND_PREV, CHUNK, H, D)
    idx = jnp.arange(nc)[:, None] + jnp.arange(BAND_PREV + 1)[None, :]
    kb = kp[:, idx].reshape(B, nc, BAND, H, D)
    vb = vp[:, idx].reshape(B, nc, BAND, H, D)
    s = jnp.einsum('bcqhd,bckhd->bhcqk', qc, kb, preferred_element_type=jnp.float32) * (D ** -0.5)
    koff = jnp.arange(BAND) - BAND_PREV * CHUNK
    rel = jnp.arange(CHUNK)[:, None] - koff[None, :]
    s = s + rel_bias_lookup(rel_bias, rel)[None, :, None]
    valid = (jnp.arange(nc)[:, None] * CHUNK + koff[None, :]) >= 0
    s = jnp.where(valid[None, None, :, None, :], s, -jnp.inf)
    p = jax.nn.softmax(s, axis=-1)
    o = jnp.einsum('bhcqk,bckhd->bcqhd', p, vb.astype(jnp.float32))
    return o.reshape(B, S, H, D).astype(q.dtype)


def chunk_band_attn_sample(q, k_new, v_new, k_past, v_past, rel_bias):
    P, T, D = k_past.shape[1], q.shape[1], q.shape[-1]
    k = jnp.concatenate([k_past, k_new], 1)
    v = jnp.concatenate([v_past, v_new], 1)
    s = jnp.einsum('bqhd,bkhd->bhqk', q, k, preferred_element_type=jnp.float32) * (D ** -0.5)
    koff = jnp.concatenate([jnp.arange(P) - P, jnp.arange(T)])
    rel = jnp.arange(T)[:, None] - koff[None, :]
    s = s + rel_bias_lookup(rel_bias, rel)[None]
    p = jax.nn.softmax(s, axis=-1)
    return jnp.einsum('bhqk,bkhd->bqhd', p, v.astype(jnp.float32)).astype(q.dtype)


def diff_attn_block(q, k, v, q_chunk, k_chunk, lam, lam_init, subln_g):
    s = jnp.einsum('bqhmd,bkhmd->bmhqk', q, k, preferred_element_type=jnp.float32) * (HD_B ** -0.5)
    vis = k_chunk[None, :] <= q_chunk[:, None]
    s = jnp.where(vis, s, -jnp.inf)
    p = jax.nn.softmax(s, axis=-1)
    a = p[:, 0] - lam * p[:, 1]
    o = jnp.einsum('bhqk,bkhe->bqhe', a, v.astype(jnp.float32))
    o = o * lax.rsqrt(jnp.mean(o * o, -1, keepdims=True) + LN_EPS) * subln_g.astype(jnp.float32) * (1.0 - lam_init)
    return o.astype(v.dtype)


def diff_attn_prompt(q, k, v, lam, lam_init, subln_g):
    B, S = q.shape[:2]
    nb = S // Q_BLOCK
    chunk_id = jnp.arange(S) // CHUNK
    qs = jnp.moveaxis(q.reshape(B, nb, Q_BLOCK, H_B, 2, HD_B), 1, 0)
    qc = chunk_id.reshape(nb, Q_BLOCK)
    o = lax.map(lambda a: diff_attn_block(a[0], k, v, a[1], chunk_id, lam, lam_init, subln_g), (qs, qc))
    return jnp.moveaxis(o, 0, 1).reshape(B, S, H_B, 2 * HD_B)


def diff_attn_sample(q, k_new, v_new, k_past, v_past, lam, lam_init, subln_g):
    P, T = k_past.shape[1], q.shape[1]
    k = jnp.concatenate([k_past, k_new], 1)
    v = jnp.concatenate([v_past, v_new], 1)
    k_chunk = jnp.concatenate([jnp.arange(P), P + jnp.arange(T)]) // CHUNK
    q_chunk = (P + jnp.arange(T)) // CHUNK
    return diff_attn_block(q, k, v, q_chunk, k_chunk, lam, lam_init, subln_g)


def merge_groups(oa, ob, w_o):
    B, S = oa.shape[:2]
    return jnp.concatenate([oa.reshape(B, S, A_WIDTH), ob.reshape(B, S, B_WIDTH)], -1) @ w_o


def mem_kv(mem, w_mk, w_mv):
    B = mem.shape[0]
    return (mem @ w_mk).reshape(B, N_MEM, H_M, HD_M), (mem @ w_mv).reshape(B, N_MEM, H_M, HD_M)


def mem_attn(x, mk, mv, w_mq, w_mo):
    B, S, _ = x.shape
    q = (x @ w_mq).reshape(B, S, H_M, HD_M)
    s = jnp.einsum('bqhd,bkhd->bhqk', q, mk, preferred_element_type=jnp.float32) * (HD_M ** -0.5)
    p = jax.nn.softmax(s, axis=-1)
    o = jnp.einsum('bhqk,bkhd->bqhd', p, mv.astype(jnp.float32)).astype(x.dtype)
    return o.reshape(B, S, D_MODEL) @ w_mo


def conv_ffn(x, conv_past, w_up, conv_w, conv_b, w_down):
    S = x.shape[1]
    u = jnp.concatenate([conv_past, x @ w_up], 1)
    c = sum(u[:, j:j + S] * conv_w[j] for j in range(CONV_W)) + conv_b
    gate, val = jnp.split(c, 2, axis=-1)
    return (jax.nn.silu(gate) * val) @ w_down, u[:, -(CONV_W - 1):]


def layer_tail(x, mix, mk, mv, conv_past, ln1_g, ln1_b, w_mq, w_mo, ln2_g, ln2_b, w_up, conv_w, conv_b, w_down, ln3_g, ln3_b):
    x = layer_norm(DEEPNORM_ALPHA * x + mix, ln1_g, ln1_b)
    x = layer_norm(DEEPNORM_ALPHA * x + mem_attn(x, mk, mv, w_mq, w_mo), ln2_g, ln2_b)
    f, conv_new = conv_ffn(x, conv_past, w_up, conv_w, conv_b, w_down)
    x = layer_norm(DEEPNORM_ALPHA * x + f, ln3_g, ln3_b)
    return x, conv_new


def setup_inputs(seed: int = 0) -> dict:
    key = jax.random.key(seed)
    ks = jax.random.split(key, 40)
    a_cache = min(BAND_PREV * CHUNK, PAST_LEN)
    n = lambda i, shape, scale=1.0: jax.random.normal(ks[i], shape, jnp.float32) * scale
    L = DEPTH
    return {
        "x_prompt": n(0, (BATCH, SEQ, D_MODEL)),
        "x_sample": n(1, (DEC_BATCH, DEC_SEQ, D_MODEL)),
        "mem_prompt": n(2, (BATCH, N_MEM, D_MODEL)),
        "cache_a_k": n(3, (L, DEC_BATCH, a_cache, H_A, HD_A)),
        "cache_a_v": n(4, (L, DEC_BATCH, a_cache, H_A, HD_A)),
        "cache_b_k": n(5, (L, DEC_BATCH, PAST_LEN, H_B, 2, HD_B)),
        "cache_b_v": n(6, (L, DEC_BATCH, PAST_LEN, H_B, 2 * HD_B)),
        "cache_mem_k": n(7, (L, DEC_BATCH, N_MEM, H_M, HD_M)),
        "cache_mem_v": n(8, (L, DEC_BATCH, N_MEM, H_M, HD_M)),
        "state_conv": n(9, (L, DEC_BATCH, CONV_W - 1, 2 * D_FF)),
        "w_qkv": n(10, (L, D_MODEL, QKV_DIM), D_MODEL ** -0.5),
        "rel_bias": n(11, (L, H_A, 2 * REL_CLIP + 1), 0.2),
        "lambda_q1": n(12, (L, HD_B), 0.1),
        "lambda_k1": n(13, (L, HD_B), 0.1),
        "lambda_q2": n(14, (L, HD_B), 0.1),
        "lambda_k2": n(15, (L, HD_B), 0.1),
        "subln_g": 1.0 + n(16, (L, 2 * HD_B), 0.02),
        "w_o": n(17, (L, MIX_WIDTH, D_MODEL), MIX_WIDTH ** -0.5 * DEEPNORM_BETA),
        "ln1_g": 1.0 + n(18, (L, D_MODEL), 0.02),
        "ln1_b": n(19, (L, D_MODEL), 0.02),
        "w_mq": n(20, (L, D_MODEL, D_MODEL), D_MODEL ** -0.5),
        "w_mk": n(21, (L, D_MODEL, D_MODEL), D_MODEL ** -0.5),
        "w_mv": n(22, (L, D_MODEL, D_MODEL), D_MODEL ** -0.5),
        "w_mo": n(23, (L, D_MODEL, D_MODEL), D_MODEL ** -0.5 * DEEPNORM_BETA),
        "ln2_g": 1.0 + n(24, (L, D_MODEL), 0.02),
        "ln2_b": n(25, (L, D_MODEL), 0.02),
        "w_up": n(26, (L, D_MODEL, 2 * D_FF), D_MODEL ** -0.5),
        "conv_w": n(27, (L, CONV_W, 2 * D_FF), CONV_W ** -0.5),
        "conv_b": n(28, (L, 2 * D_FF), 0.02),
        "w_down": n(29, (L, D_FF, D_MODEL), D_FF ** -0.5 * DEEPNORM_BETA),
        "ln3_g": 1.0 + n(30, (L, D_MODEL), 0.02),
        "ln3_b": n(31, (L, D_MODEL), 0.02),
    }


def reference(x_prompt, x_sample, mem_prompt, cache_a_k, cache_a_v, cache_b_k, cache_b_v, cache_mem_k, cache_mem_v, state_conv,
              w_qkv, rel_bias, lambda_q1, lambda_k1, lambda_q2, lambda_k2, subln_g, w_o, ln1_g, ln1_b,
              w_mq, w_mk, w_mv, w_mo, ln2_g, ln2_b, w_up, conv_w, conv_b, w_down, ln3_g, ln3_b):
    xp, xs = x_prompt, x_sample
    B, S = xp.shape[:2]
    Bd, T = xs.shape[:2]
    P = cache_b_k.shape[2]
    pos_p = jnp.arange(S)
    pos_s = P + jnp.arange(T)
    keep = min(BAND_PREV * CHUNK, S)
    akp, avp, bkp, bvp, mkp, mvp, cvp = [], [], [], [], [], [], []
    aks, avs, bks, bvs, cvs = [], [], [], [], []
    for l in range(DEPTH):
        lam_init = 0.8 - 0.6 * math.exp(-0.3 * l)
        lam = (jnp.exp(jnp.sum(lambda_q1[l].astype(jnp.float32) * lambda_k1[l].astype(jnp.float32)))
               - jnp.exp(jnp.sum(lambda_q2[l].astype(jnp.float32) * lambda_k2[l].astype(jnp.float32))) + lam_init)
        tail = (ln1_g[l], ln1_b[l], w_mq[l], w_mo[l], ln2_g[l], ln2_b[l], w_up[l], conv_w[l], conv_b[l], w_down[l], ln3_g[l], ln3_b[l])
        qa, ka, va, qb, kb, vb = project_groups(xp, w_qkv[l], pos_p)
        oa = chunk_band_attn_prompt(qa, ka, va, rel_bias[l])
        ob = diff_attn_prompt(qb, kb, vb, lam, lam_init, subln_g[l])
        mk, mv = mem_kv(mem_prompt, w_mk[l], w_mv[l])
        conv0 = jnp.zeros((B, CONV_W - 1, 2 * D_FF), xp.dtype)
        xp, conv_p = layer_tail(xp, merge_groups(oa, ob, w_o[l]), mk, mv, conv0, *tail)
        akp.append(ka[:, S - keep:]); avp.append(va[:, S - keep:])
        bkp.append(kb); bvp.append(vb); mkp.append(mk); mvp.append(mv); cvp.append(conv_p)
        qa, ka, va, qb, kb, vb = project_groups(xs, w_qkv[l], pos_s)
        oa = chunk_band_attn_sample(qa, ka, va, cache_a_k[l], cache_a_v[l], rel_bias[l])
        ob = diff_attn_sample(qb, kb, vb, cache_b_k[l], cache_b_v[l], lam, lam_init, subln_g[l])
        xs, conv_s = layer_tail(xs, merge_groups(oa, ob, w_o[l]), cache_mem_k[l], cache_mem_v[l], state_conv[l], *tail)
        aks.append(ka); avs.append(va); bks.append(kb); bvs.append(vb); cvs.append(conv_s)
    st = lambda xs_: jnp.stack(xs_, 0)
    return (xp, xs, st(akp), st(avp), st(bkp), st(bvp), st(mkp), st(mvp), st(cvp), st(aks), st(avs), st(bks), st(bvs), st(cvs))
```

```cpp
#include <hip/hip_runtime.h>
#include <cstdio>
#include <cstdint>

#define LAS __attribute__((address_space(3)))
#define GAS __attribute__((address_space(1)))
typedef unsigned short bf16_t;
typedef short bf16x8 __attribute__((ext_vector_type(8)));
typedef short s16x4 __attribute__((ext_vector_type(4)));
typedef float f32x2 __attribute__((ext_vector_type(2)));
typedef float f32x4 __attribute__((ext_vector_type(4)));
typedef float f32x16 __attribute__((ext_vector_type(16)));
typedef unsigned u32x2 __attribute__((ext_vector_type(2)));
typedef unsigned u32x4 __attribute__((ext_vector_type(4)));
typedef __bf16 bf16x2_t __attribute__((ext_vector_type(2)));

constexpr int DM = 1024, SEQ = 16384, NSAMP = 256, MROWS = SEQ + NSAMP;
constexpr int NQKV = 3072, DFF = 2816, DFF2 = 5632;
constexpr float LN_EPS = 1e-5f;
constexpr float ALPHA = 1.189207115002721f;
constexpr float LOG2E = 1.4426950408889634f;
constexpr float C2 = 0.125f * LOG2E;
constexpr float C2M = 0.0625f * LOG2E;
constexpr size_t OFF_Y = 0, OFF_AKP = 17039360, OFF_AVP = 17301504, OFF_BKP = 17563648, OFF_BVP = 25952256, OFF_MKP = 34340864, OFF_MVP = 34603008,
                 OFF_CVP = 34865152, OFF_AKS = 34876416, OFF_AVS = 35007488, OFF_BKS = 35138560, OFF_BVS = 35269632, OFF_CVS = 35400704;
constexpr size_t MiB = 1u << 20;
constexpr size_t WS_CTL = 0, CTL_ZERO_BYTES = 1 * MiB;
constexpr size_t WS_ROPE = 1 * MiB, WS_BT = 2 * MiB, WS_LAM = 2 * MiB + 32768;
constexpr size_t WS_WQKV = 3 * MiB, WS_WO = 9 * MiB, WS_WMQ = 11 * MiB, WS_WMKV = 13 * MiB, WS_WMO = 17 * MiB, WS_WUP = 19 * MiB, WS_WDN = 30 * MiB;
constexpr size_t WS_MEMB = 36 * MiB, WS_MKB = 36 * MiB + 512 * 1024, WS_MVB = 37 * MiB;
constexpr size_t WS_KAS = 38 * MiB, WS_VAS = 42 * MiB + 512 * 1024, WS_KBS = 47 * MiB, WS_VBS = 55 * MiB + 512 * 1024, WS_MKS = 64 * MiB, WS_MVS = 68 * MiB;
constexpr size_t WS_QKVB = 72 * MiB, WS_XB = 170 * MiB, WS_OD = 170 * MiB, WS_MIXA = 203 * MiB, WS_X1B = 203 * MiB, WS_X2B = 203 * MiB + 4096;
constexpr size_t WS_QM = 72 * MiB, WS_OM = 105 * MiB, WS_H = 72 * MiB;

__device__ __forceinline__ unsigned cvtpk(float lo, float hi) { f32x2 v = {lo, hi}; bf16x2_t b = __builtin_convertvector(v, bf16x2_t); return __builtin_bit_cast(unsigned, b); }
__device__ __forceinline__ bf16_t f2bf(float f) { return (bf16_t)(cvtpk(f, 0.f) & 0xffffu); }

namespace pg8 {
constexpr int BM = 256, BK = 64, HALF = 128, HTB = HALF * BK * 2, STAGE_BYTES = 8 * HTB, NXCD = 8, WGM = 8;
__host__ __device__ __forceinline__ int lds_byte(int r, int c) { const int st = (r >> 4) * 2 + (c >> 5), rr = r & 15, cc = c & 31, ob = rr * 64 + cc * 2; return st * 1024 + (ob ^ (((ob >> 9) & 1) << 5)); }
__host__ __device__ __forceinline__ void stage_rc(int b, int& R, int& C) { const int st = b / 1024, sb = b % 1024, swz = sb ^ (((sb >> 9) & 1) << 5); R = (st >> 1) * 16 + swz / 64; C = (st & 1) * 32 + (swz % 64) / 2; }
__host__ __device__ __forceinline__ int perm32(int rho) { const int n = rho >> 4, i = rho & 15; return 8 * (i >> 2) + 4 * n + (i & 3); }
struct Unit { int pm, pn; };
struct Gemm { const bf16_t* A; const bf16_t* Bt; int lda, ldb, K; };
struct StaticOrder {
    int nM, nN, nwg, G, c;
    __host__ __device__ void init(int nM_, int nN_, int G_, int c_) { nM = nM_; nN = nN_; nwg = nM * nN; G = G_; c = c_; }
    __host__ __device__ bool next(int i, Unit& u) const {
        const long L = (long)i * G + c; if (L >= nwg) return false;
        int wgid = (int)L; { const int q = nwg / NXCD, r = nwg % NXCD, xcd = wgid % NXCD, off = wgid / NXCD; wgid = (xcd < r ? xcd * (q + 1) : r * (q + 1) + (xcd - r) * q) + off; }
        const int nig = WGM * nN, gid = wgid / nig, fm = gid * WGM, gsz = (nM - fm) < WGM ? (nM - fm) : WGM;
        u.pm = fm + ((wgid % nig) % gsz); u.pn = (wgid % nig) / gsz; return true;
    }
};
template <class Epi, int AMODE, bool ALIGN_EPI, bool SP2>
__device__ __forceinline__ void gemm_phase(LAS unsigned char* lds, const Gemm g, const StaticOrder& S, const Epi& E) {
    const int tid = threadIdx.x, wid = __builtin_amdgcn_readfirstlane(tid >> 6), lane = tid & 63, wr = wid >> 2, wc = wid & 3, fr = lane & 15, fq = lane >> 4;
    const int K = g.K, nt = K / BK;
    unsigned voffA[2], voffB[2];
#pragma unroll
    for (int i = 0; i < 2; ++i) { int R, C; stage_rc(tid * 16 + i * 8192, R, C); const int Rb = Epi::PERM ? ((R & ~31) + perm32(R & 31)) : R;
        const int Ra = (AMODE == 1) ? (62 * (R >> 6) + (R & 63)) : R;
        voffA[i] = (unsigned)(Ra * g.lda + C) * 2u; voffB[i] = (unsigned)(Rb * g.ldb + C) * 2u; }
    const size_t kstep = (size_t)(BK * 2);
    const size_t hstepA = (size_t)((AMODE == 1) ? 124 : 128) * g.lda * 2, hstepB = (size_t)HALF * g.ldb * 2;
    const unsigned ldsw = (unsigned)wid * 1024u;
    const int aoff = lds_byte(wr * 64 + fr, fq * 8), boff = lds_byte(wc * 32 + fr, fq * 8);
#define PG8_TILEA(pm) ((const char*)g.A + (ptrdiff_t)((AMODE == 1) ? (248 * (pm) - 2) : (256 * (pm))) * g.lda * 2)
#define PG8_TILEB(pn) ((const char*)g.Bt + (size_t)(256 * (pn)) * g.ldb * 2)
#define PG8_SA(b, h) (((b) * 2 + (h)) * HTB)
#define PG8_SB(b, h) ((4 + (b) * 2 + (h)) * HTB)
#define PG8_STAGE(bufoff, gbase, voff) do { _Pragma("unroll") for (int _i = 0; _i < 2; ++_i) \
        __builtin_amdgcn_global_load_lds((const unsigned*)((const char*)(gbase) + (voff)[_i]), (LAS unsigned*)(lds + (bufoff) + ldsw + _i * 8192), 16, 0, 0); } while (0)
#define PG8_LDA(dst, b, h) do { _Pragma("unroll") for (int m = 0; m < 4; ++m) _Pragma("unroll") for (int k = 0; k < 2; ++k) dst[m][k] = *(const LAS bf16x8*)(lds + PG8_SA(b, h) + aoff + m * 2048 + k * 1024); } while (0)
#define PG8_LDB(dst, b, h) do { _Pragma("unroll") for (int n = 0; n < 2; ++n) _Pragma("unroll") for (int k = 0; k < 2; ++k) dst[n][k] = *(const LAS bf16x8*)(lds + PG8_SB(b, h) + boff + n * 2048 + k * 1024); } while (0)
#define PG8_MMA(ai, bj, At, Bt) do { __builtin_amdgcn_s_setprio(1); _Pragma("unroll") for (int m = 0; m < 4; ++m) _Pragma("unroll") for (int n = 0; n < 2; ++n) _Pragma("unroll") for (int k = 0; k < 2; ++k) \
        acc[ai][bj][m][n] = __builtin_amdgcn_mfma_f32_16x16x32_bf16(Bt[n][k], At[m][k], acc[ai][bj][m][n], 0, 0, 0); __builtin_amdgcn_s_setprio(0); } while (0)
#define PG8_WAIT_V(n) asm volatile("s_waitcnt vmcnt(" #n ")" ::: "memory")
#define PG8_WAIT_L(n) asm volatile("s_waitcnt lgkmcnt(" #n ")" ::: "memory")
#define PG8_BAR __builtin_amdgcn_s_barrier()
#define PG8_SCHED __builtin_amdgcn_sched_barrier(0)
    Unit cur, nxt; int ui = 0;
    if (!S.next(0, cur)) return;
    f32x4 acc[2][2][4][2];
#pragma unroll
    for (int a = 0; a < 2; ++a)
#pragma unroll
        for (int b = 0; b < 2; ++b)
#pragma unroll
            for (int m = 0; m < 4; ++m)
#pragma unroll
                for (int n = 0; n < 2; ++n) acc[a][b][m][n] = (f32x4){0.f, 0.f, 0.f, 0.f};
    bf16x8 At[4][2], B0[2][2], B1[2][2];
    const char* cA = PG8_TILEA(cur.pm); const char* cB = PG8_TILEB(cur.pn);
    if constexpr (SP2) {
        PG8_STAGE(PG8_SB(0, 0), cB, voffB); PG8_STAGE(PG8_SB(0, 1), cB + hstepB, voffB); PG8_STAGE(PG8_SA(0, 0), cA, voffA); PG8_STAGE(PG8_SA(0, 1), cA + hstepA, voffA);
        if (wr == 1) PG8_BAR;
        PG8_WAIT_V(2); PG8_BAR;
        PG8_STAGE(PG8_SB(1, 0), cB + kstep, voffB); PG8_STAGE(PG8_SA(1, 0), cA + kstep, voffA); PG8_STAGE(PG8_SB(1, 1), cB + hstepB + kstep, voffB);
        PG8_WAIT_V(6); PG8_BAR;
    } else {
        PG8_STAGE(PG8_SB(0, 0), cB, voffB); PG8_STAGE(PG8_SA(0, 0), cA, voffA); PG8_STAGE(PG8_SB(0, 1), cB + hstepB, voffB); PG8_STAGE(PG8_SA(0, 1), cA + hstepA, voffA);
        if (wr == 1) PG8_BAR;
        PG8_WAIT_V(4); PG8_BAR;
        PG8_STAGE(PG8_SB(1, 0), cB + kstep, voffB); PG8_STAGE(PG8_SA(1, 0), cA + kstep, voffA); PG8_STAGE(PG8_SB(1, 1), cB + hstepB + kstep, voffB);
        PG8_WAIT_V(6); PG8_BAR;
    }
    for (;;) {
        const bool has_next = S.next(ui + 1, nxt);
        const char* nA = has_next ? PG8_TILEA(nxt.pm) : cA; const char* nB = has_next ? PG8_TILEB(nxt.pn) : cB;
        for (int t = 0; t < nt; t += 2) {
            const bool last = (t == nt - 2);
            const char* a1 = cA + (size_t)(t + 1) * kstep;
            const char* a2 = last ? nA : cA + (size_t)(t + 2) * kstep; const char* b2 = last ? nB : cB + (size_t)(t + 2) * kstep;
            const char* a3 = a2 + kstep; const char* b3 = b2 + kstep;
            if constexpr (SP2) {
            PG8_LDB(B0, 0, 0); PG8_LDB(B1, 0, 1); PG8_SCHED; PG8_LDA(At, 0, 0); PG8_STAGE(PG8_SA(1, 1), a1 + hstepA, voffA);
            PG8_WAIT_V(8); PG8_WAIT_L(0); PG8_BAR; PG8_MMA(0, 0, At, B0); PG8_MMA(0, 1, At, B1); PG8_BAR; PG8_SCHED;
            PG8_LDA(At, 0, 1); PG8_STAGE(PG8_SB(0, 0), b2, voffB); PG8_STAGE(PG8_SB(0, 1), b2 + hstepB, voffB); PG8_STAGE(PG8_SA(0, 0), a2, voffA);
            PG8_WAIT_V(8); PG8_WAIT_L(0); PG8_BAR; PG8_MMA(1, 0, At, B0); PG8_MMA(1, 1, At, B1); PG8_BAR; PG8_SCHED;
            PG8_LDB(B0, 1, 0); PG8_LDB(B1, 1, 1); PG8_SCHED; PG8_LDA(At, 1, 0); PG8_STAGE(PG8_SA(0, 1), a2 + hstepA, voffA);
            PG8_WAIT_V(8); PG8_WAIT_L(0); PG8_BAR; PG8_MMA(0, 0, At, B0); PG8_MMA(0, 1, At, B1); PG8_BAR; PG8_SCHED;
            PG8_LDA(At, 1, 1); PG8_STAGE(PG8_SB(1, 0), b3, voffB); PG8_STAGE(PG8_SB(1, 1), b3 + hstepB, voffB); PG8_STAGE(PG8_SA(1, 0), a3, voffA);
            PG8_WAIT_V(8); PG8_WAIT_L(0); PG8_BAR; PG8_MMA(1, 0, At, B0); PG8_MMA(1, 1, At, B1); PG8_BAR; PG8_SCHED;
            } else {
            PG8_LDB(B0, 0, 0); PG8_SCHED; PG8_LDA(At, 0, 0); PG8_STAGE(PG8_SA(1, 1), a1 + hstepA, voffA);
            PG8_WAIT_L(8); PG8_BAR; PG8_WAIT_L(0); PG8_MMA(0, 0, At, B0); PG8_BAR; PG8_SCHED;
            PG8_LDB(B1, 0, 1); PG8_STAGE(PG8_SB(0, 0), b2, voffB);
            PG8_BAR; PG8_WAIT_L(0); PG8_MMA(0, 1, At, B1); PG8_BAR;
            PG8_LDA(At, 0, 1); PG8_STAGE(PG8_SA(0, 0), a2, voffA);
            PG8_BAR; PG8_WAIT_L(0); PG8_MMA(1, 0, At, B0); PG8_BAR; PG8_SCHED;
            PG8_STAGE(PG8_SB(0, 1), b2 + hstepB, voffB);
            PG8_WAIT_V(6); PG8_BAR; PG8_MMA(1, 1, At, B1); PG8_BAR;
            PG8_LDB(B0, 1, 0); PG8_SCHED; PG8_LDA(At, 1, 0); PG8_STAGE(PG8_SA(0, 1), a2 + hstepA, voffA);
            PG8_WAIT_L(8); PG8_BAR; PG8_WAIT_L(0); PG8_MMA(0, 0, At, B0); PG8_BAR; PG8_SCHED;
            PG8_LDB(B1, 1, 1); PG8_STAGE(PG8_SB(1, 0), b3, voffB);
            PG8_BAR; PG8_WAIT_L(0); PG8_MMA(0, 1, At, B1); PG8_BAR;
            PG8_LDA(At, 1, 1); PG8_STAGE(PG8_SA(1, 0), a3, voffA);
            PG8_BAR; PG8_WAIT_L(0); PG8_MMA(1, 0, At, B0); PG8_BAR; PG8_SCHED;
            PG8_STAGE(PG8_SB(1, 1), b3 + hstepB, voffB);
            PG8_WAIT_V(6); PG8_BAR; PG8_MMA(1, 1, At, B1); PG8_BAR;
            }
        }
        if constexpr (ALIGN_EPI) { if (wr == 0) PG8_BAR; }
        E(acc, cur, wr, wc, fr, fq);
        if (!has_next) break;
#pragma unroll
        for (int a = 0; a < 2; ++a)
#pragma unroll
            for (int b = 0; b < 2; ++b)
#pragma unroll
                for (int m = 0; m < 4; ++m)
#pragma unroll
                    for (int n = 0; n < 2; ++n) acc[a][b][m][n] = (f32x4){0.f, 0.f, 0.f, 0.f};
        cur = nxt; cA = nA; cB = nB; ++ui;
        if constexpr (ALIGN_EPI) { if (wr == 1) PG8_BAR; }
    }
    PG8_WAIT_V(0);
    if constexpr (!ALIGN_EPI) { if (wr == 0) PG8_BAR; }
    PG8_BAR;
#undef PG8_TILEA
#undef PG8_TILEB
#undef PG8_SA
#undef PG8_SB
#undef PG8_STAGE
#undef PG8_LDA
#undef PG8_LDB
#undef PG8_MMA
#undef PG8_WAIT_V
#undef PG8_WAIT_L
#undef PG8_BAR
#undef PG8_SCHED
}

struct EpiQKV {
    static constexpr bool PERM = true;
    bf16_t* qkvb; float* out; const float* rope; bf16_t *kas, *vas, *kbs, *vbs;
    __device__ __forceinline__ void operator()(const f32x4 (&acc)[2][2][4][2], const Unit& u, int wr, int wc, int fr, int fq) const {
        const int pn = u.pn, pm = u.pm, region = pn >> 1;
        const bool isq = (region == 0) || (region == 3);
        const float sc = isq ? C2 : 1.f;
        const bool rope_on = (pn >= 6 && pn < 10) && ((wc & 1) == 0);
#pragma unroll
        for (int ai = 0; ai < 2; ++ai)
#pragma unroll
            for (int m = 0; m < 4; ++m) {
                const int lr = ai * 128 + wr * 64 + m * 16 + fr, grow = pm * 256 + lr;
                f32x4 cs0 = {1.f, 1.f, 1.f, 1.f}, cs1 = cs0, sn0 = {0.f, 0.f, 0.f, 0.f}, sn1 = sn0;
                if (rope_on) { const int pos = (grow < SEQ) ? grow : 1024 + ((grow - SEQ) & 31); const f32x4* rp = (const f32x4*)(rope + (size_t)pos * 16);
                    cs0 = rp[0]; cs1 = rp[1]; sn0 = rp[2]; sn1 = rp[3]; }
#pragma unroll
                for (int bj = 0; bj < 2; ++bj) {
                    f32x4 v0 = acc[ai][bj][m][0], v1 = acc[ai][bj][m][1];
                    const int c8 = pn * 256 + bj * 128 + wc * 32 + fq * 8, cr = c8 - region * 512;
                    if (rope_on) {
                        f32x4 p0, p1;
#pragma unroll
                        for (int j = 0; j < 4; ++j) { p0[j] = __shfl_xor(v0[j], 16); p1[j] = __shfl_xor(v1[j], 16); }
                        if (fq == 0) { v0 = v0 * cs0 - p0 * sn0; v1 = v1 * cs1 - p1 * sn1; }
                        else if (fq == 1) { v0 = v0 * cs0 + p0 * sn0; v1 = v1 * cs1 + p1 * sn1; }
                    }
                    float* fo = nullptr;
                    if (region == 1 || region == 2) {
                        if (pm == 64) fo = out + (region == 1 ? OFF_AKS : OFF_AVS) + (size_t)(grow - SEQ) * 512 + cr;
                        else if (grow >= SEQ - 512) fo = out + (region == 1 ? OFF_AKP : OFF_AVP) + (size_t)(grow - (SEQ - 512)) * 512 + cr;
                    } else if (region == 4 || region == 5) {
                        if (pm == 64) fo = out + (region == 4 ? OFF_BKS : OFF_BVS) + (size_t)(grow - SEQ) * 512 + cr;
                        else fo = out + (region == 4 ? OFF_BKP : OFF_BVP) + (size_t)grow * 512 + cr;
                    }
                    if (fo) { *(f32x4*)fo = v0; *(f32x4*)(fo + 4) = v1; }
                    u32x4 w; w.x = cvtpk(v0[0] * sc, v0[1] * sc); w.y = cvtpk(v0[2] * sc, v0[3] * sc); w.z = cvtpk(v1[0] * sc, v1[1] * sc); w.w = cvtpk(v1[2] * sc, v1[3] * sc);
                    *(u32x4*)(qkvb + (size_t)grow * NQKV + c8) = w;
                    if (pm == 64) { const int b = (grow - SEQ) >> 5, t = (grow - SEQ) & 31;
                        if (region == 1) *(u32x4*)(kas + ((size_t)(b * 544 + 512 + t)) * 512 + cr) = w;
                        else if (region == 2) *(u32x4*)(vas + ((size_t)(b * 544 + 512 + t)) * 512 + cr) = w;
                        else if (region == 4) *(u32x4*)(kbs + ((size_t)(b * 1056 + 1024 + t)) * 512 + cr) = w;
                        else if (region == 5) *(u32x4*)(vbs + ((size_t)(b * 1056 + 1024 + t)) * 512 + cr) = w; }
                }
            }
    }
};
struct EpiMemKV {
    static constexpr bool PERM = true;
    float* out; bf16_t *mkb, *mvb;
    __device__ __forceinline__ void operator()(const f32x4 (&acc)[2][2][4][2], const Unit& u, int wr, int wc, int fr, int fq) const {
        const bool isv = u.pn >= 4;
        float* fb = out + (isv ? OFF_MVP : OFF_MKP); bf16_t* bb = isv ? mvb : mkb;
#pragma unroll
        for (int ai = 0; ai < 2; ++ai)
#pragma unroll
            for (int m = 0; m < 4; ++m) { const int lr = ai * 128 + wr * 64 + m * 16 + fr;
#pragma unroll
                for (int bj = 0; bj < 2; ++bj) { const f32x4 v0 = acc[ai][bj][m][0], v1 = acc[ai][bj][m][1];
                    const int c8 = (u.pn & 3) * 256 + bj * 128 + wc * 32 + fq * 8;
                    *(f32x4*)(fb + (size_t)lr * 1024 + c8) = v0; *(f32x4*)(fb + (size_t)lr * 1024 + c8 + 4) = v1;
                    u32x4 w; w.x = cvtpk(v0[0], v0[1]); w.y = cvtpk(v0[2], v0[3]); w.z = cvtpk(v1[0], v1[1]); w.w = cvtpk(v1[2], v1[3]);
                    *(u32x4*)(bb + (size_t)lr * 1024 + c8) = w; } }
    }
};
struct EpiResid {
    static constexpr bool PERM = false;
    const float* base0; const float* base1; float* out;
    __device__ __forceinline__ void operator()(const f32x4 (&acc)[2][2][4][2], const Unit& u, int wr, int wc, int fr, int fq) const {
#pragma unroll
        for (int ai = 0; ai < 2; ++ai)
#pragma unroll
            for (int m = 0; m < 4; ++m) { const int grow = u.pm * 256 + ai * 128 + wr * 64 + m * 16 + fr;
                const float* bp = (u.pm < 64) ? base0 + (size_t)grow * DM : base1 + (size_t)(grow - SEQ) * DM; float* op = out + (size_t)grow * DM;
#pragma unroll
                for (int bj = 0; bj < 2; ++bj)
#pragma unroll
                    for (int n = 0; n < 2; ++n) { const int col = u.pn * 256 + bj * 128 + wc * 32 + n * 16 + fq * 4;
                        const f32x4 b = *(const f32x4*)(bp + col); *(f32x4*)(op + col) = b * ALPHA + acc[ai][bj][m][n]; } }
    }
};
struct EpiBf16S {
    static constexpr bool PERM = true;
    bf16_t* O; int ldc; float scale;
    __device__ __forceinline__ void operator()(const f32x4 (&acc)[2][2][4][2], const Unit& u, int wr, int wc, int fr, int fq) const {
#pragma unroll
        for (int ai = 0; ai < 2; ++ai)
#pragma unroll
            for (int m = 0; m < 4; ++m) { const int grow = u.pm * 256 + ai * 128 + wr * 64 + m * 16 + fr;
#pragma unroll
                for (int bj = 0; bj < 2; ++bj) { const f32x4 v0 = acc[ai][bj][m][0] * scale, v1 = acc[ai][bj][m][1] * scale;
                    const int c8 = u.pn * 256 + bj * 128 + wc * 32 + fq * 8;
                    u32x4 w; w.x = cvtpk(v0[0], v0[1]); w.y = cvtpk(v0[2], v0[3]); w.z = cvtpk(v1[0], v1[1]); w.w = cvtpk(v1[2], v1[3]);
                    *(u32x4*)(O + (size_t)grow * ldc + c8) = w; } }
    }
};
template <bool SAMPLE> struct EpiUpConv {
    static constexpr bool PERM = true;
    bf16_t* H; const float* cw; const float* cb; const float* state; float* convp; float* convs;
    __device__ __forceinline__ void operator()(const f32x4 (&acc)[2][2][4][2], const Unit& u, int wr, int wc, int fr, int fq) const {
        const int lane = threadIdx.x & 63;
        const int src1 = (lane & 48) | ((lane - 1) & 15), src2 = (lane & 48) | ((lane - 2) & 15);
#pragma unroll
        for (int n = 0; n < 2; ++n) {
            const int gcol = u.pn * 128 + wc * 32 + fq * 8 + 4 * n;
            const f32x4 w0g = *(const f32x4*)(cw + gcol), w1g = *(const f32x4*)(cw + DFF2 + gcol), w2g = *(const f32x4*)(cw + 2 * DFF2 + gcol), bg = *(const f32x4*)(cb + gcol);
            const f32x4 w0v = *(const f32x4*)(cw + DFF + gcol), w1v = *(const f32x4*)(cw + DFF2 + DFF + gcol), w2v = *(const f32x4*)(cw + 2 * DFF2 + DFF + gcol), bv = *(const f32x4*)(cb + DFF + gcol);
#pragma unroll
            for (int ai = 0; ai < 2; ++ai)
#pragma unroll
                for (int m = 0; m < 4; ++m) {
                    const int lr = ai * 128 + wr * 64 + m * 16 + fr, rho = m * 16 + fr;
                    const f32x4 ug = acc[ai][0][m][n], uv = acc[ai][1][m][n];
                    const f32x4 pg = (m > 0) ? acc[ai][0][m - 1][n] : ug, pv = (m > 0) ? acc[ai][1][m - 1][n] : uv;
                    f32x4 t1g, t2g, t1v, t2v, p1g, p2g, p1v, p2v;
#pragma unroll
                    for (int j = 0; j < 4; ++j) { t1g[j] = (fr == 15) ? pg[j] : ug[j]; t2g[j] = (fr >= 14) ? pg[j] : ug[j]; t1v[j] = (fr == 15) ? pv[j] : uv[j]; t2v[j] = (fr >= 14) ? pv[j] : uv[j]; }
#pragma unroll
                    for (int j = 0; j < 4; ++j) { p1g[j] = __shfl(t1g[j], src1); p2g[j] = __shfl(t2g[j], src2); p1v[j] = __shfl(t1v[j], src1); p2v[j] = __shfl(t2v[j], src2); }
                    int grow; bool valid;
                    if (SAMPLE) {
                        grow = SEQ + lr; valid = true;
                        if ((m & 1) == 0) {
                            const int b = lr >> 5;
                            if (fr < 2) { const float* s0 = state + (size_t)(b * 2) * DFF2 + gcol; const float* s1 = s0 + DFF2;
                                const f32x4 s0g = *(const f32x4*)s0, s1g = *(const f32x4*)s1, s0v = *(const f32x4*)(s0 + DFF), s1v = *(const f32x4*)(s1 + DFF);
                                if (fr == 0) { p1g = s1g; p2g = s0g; p1v = s1v; p2v = s0v; } else { p2g = s1g; p2v = s1v; } }
                        }
                        const int t = lr & 31;
                        if (t >= 30) { float* cp = convs + (size_t)((lr >> 5) * 2 + (t - 30)) * DFF2 + gcol; *(f32x4*)cp = ug; *(f32x4*)(cp + DFF) = uv; }
                    } else {
                        grow = 62 * (4 * u.pm + 2 * ai + wr) + rho - 2; valid = (rho >= 2) && (grow < SEQ);
                        if (valid && grow >= SEQ - 2) { float* cp = convp + (size_t)(grow - (SEQ - 2)) * DFF2 + gcol; *(f32x4*)cp = ug; *(f32x4*)(cp + DFF) = uv; }
                    }
                    const f32x4 cg = w2g * ug + w1g * p1g + w0g * p2g + bg, cv = w2v * uv + w1v * p1v + w0v * p2v + bv;
                    f32x4 h;
#pragma unroll
                    for (int j = 0; j < 4; ++j) h[j] = cg[j] * __builtin_amdgcn_rcpf(1.f + __builtin_amdgcn_exp2f(-LOG2E * cg[j])) * cv[j];
                    if (valid) { u32x2 w; w.x = cvtpk(h[0], h[1]); w.y = cvtpk(h[2], h[3]); *(u32x2*)(H + (size_t)grow * DFF + gcol) = w; }
                }
        }
    }
};
}

__device__ __forceinline__ int crow(int r, int hi) { return (r & 3) + 8 * (r >> 2) + 4 * hi; }
typedef short v4i16_t __attribute__((ext_vector_type(4)));
__device__ __forceinline__ s16x4 vtr(const LAS unsigned char* p) { return __builtin_bit_cast(s16x4, __builtin_amdgcn_ds_read_tr16_b64_v4i16((LAS v4i16_t*)p)); }
template <int DQ, bool BIAS>
__device__ __forceinline__ void gsa_wave(const bf16_t* Q, int qp, const bf16_t* K, int kp, const bf16_t* V, int vp, int nkeys, const float* btab, int relbase,
                                         bf16_t* O, int op, LAS unsigned char* wl, int lane) {
    const int r32 = lane & 31, hi = lane >> 5;
    LAS float* wsf = (LAS float*)(wl + 4096);
    bf16x8 qr[DQ / 16];
#pragma unroll
    for (int d0 = 0; d0 < DQ / 16; ++d0) qr[d0] = *(const bf16x8*)(Q + (size_t)r32 * qp + d0 * 16 + hi * 8);
    f32x16 o0 = {}, o1 = {};
    float mrun = -INFINITY, l = 0.f;
    const LAS unsigned char* vb = wl + (4 * hi + ((lane & 15) >> 2)) * 64 + ((lane >> 4) & 1) * 32 + (lane & 3) * 8;
    for (int k0 = 0; k0 < nkeys; k0 += 32) {
        u32x4 vreg[4];
#pragma unroll
        for (int i = 0; i < 4; ++i) { const int idx = i * 64 + lane, key = idx >> 3, ch = idx & 7; vreg[i] = *(const u32x4*)(V + (size_t)(k0 + key) * vp + ch * 8); }
        f32x16 s = {};
#pragma unroll
        for (int d0 = 0; d0 < DQ / 16; ++d0) { const bf16x8 kf = *(const bf16x8*)(K + (size_t)(k0 + r32) * kp + d0 * 16 + hi * 8); s = __builtin_amdgcn_mfma_f32_32x32x16_bf16(kf, qr[d0], s, 0, 0, 0); }
#pragma unroll
        for (int i = 0; i < 4; ++i) { const int idx = i * 64 + lane, key = idx >> 3, ch = idx & 7; *(LAS u32x4*)(wl + ((ch >> 2) * 2 + (key >> 4)) * 1024 + (key & 15) * 64 + (ch & 3) * 16) = vreg[i]; }
        if (BIAS) {
#pragma unroll
            for (int r = 0; r < 16; ++r) s[r] += btab[relbase + r32 - (k0 + crow(r, hi))];
        }
        float mx = s[0];
#pragma unroll
        for (int r = 1; r < 16; ++r) mx = fmaxf(mx, s[r]);
        mx = fmaxf(mx, __shfl_xor(mx, 32));
        const float mnew = fmaxf(mrun, mx), alpha = __builtin_amdgcn_exp2f(mrun - mnew);
        float rs = 0.f;
#pragma unroll
        for (int r = 0; r < 16; ++r) { s[r] = __builtin_amdgcn_exp2f(s[r] - mnew); rs += s[r]; }
        rs += __shfl_xor(rs, 32);
        l = l * alpha + rs; mrun = mnew;
        if (hi == 0) wsf[r32] = alpha;
        asm volatile("s_waitcnt lgkmcnt(0)" ::: "memory");
#pragma unroll
        for (int g = 0; g < 4; ++g) { const f32x4 a4 = *(const LAS f32x4*)(wsf + 8 * g + 4 * hi);
#pragma unroll
            for (int j = 0; j < 4; ++j) { o0[4 * g + j] *= a4[j]; o1[4 * g + j] *= a4[j]; } }
        u32x4 pw0, pw1;
        pw0.x = cvtpk(s[0], s[1]); pw0.y = cvtpk(s[2], s[3]); pw0.z = cvtpk(s[4], s[5]); pw0.w = cvtpk(s[6], s[7]);
        pw1.x = cvtpk(s[8], s[9]); pw1.y = cvtpk(s[10], s[11]); pw1.z = cvtpk(s[12], s[13]); pw1.w = cvtpk(s[14], s[15]);
#pragma unroll
        for (int d0 = 0; d0 < 2; ++d0)
#pragma unroll
            for (int ks = 0; ks < 2; ++ks) {
                const s16x4 lo = vtr(vb + (d0 * 2 + ks) * 1024), hh = vtr(vb + (d0 * 2 + ks) * 1024 + 512);
                const bf16x8 vf = {lo[0], lo[1], lo[2], lo[3], hh[0], hh[1], hh[2], hh[3]};
                const bf16x8 pa = __builtin_bit_cast(bf16x8, ks == 0 ? pw0 : pw1);
                if (d0 == 0) o0 = __builtin_amdgcn_mfma_f32_32x32x16_bf16(pa, vf, o0, 0, 0, 0); else o1 = __builtin_amdgcn_mfma_f32_32x32x16_bf16(pa, vf, o1, 0, 0, 0);
            }
        asm volatile("s_waitcnt lgkmcnt(0)" ::: "memory");
    }
    if (hi == 0) wsf[r32] = 1.f / l;
    asm volatile("s_waitcnt lgkmcnt(0)" ::: "memory");
#pragma unroll
    for (int r = 0; r < 16; ++r) { const int q = crow(r, hi); const float rl = wsf[q];
        O[(size_t)q * op + r32] = f2bf(o0[r] * rl); O[(size_t)q * op + 32 + r32] = f2bf(o1[r] * rl); }
    asm volatile("s_waitcnt lgkmcnt(0)" ::: "memory");
}

typedef GAS unsigned gu32;
#define RLX_AGENT __ATOMIC_RELAXED, __HIP_MEMORY_SCOPE_AGENT
#define XB_TMO      128
#define XB_XCNT(j)  (256  + 64 * (j))
#define XB_XSUB(j)  (1280 + 64 * (j))
#define XB_XGEN(j)  (2304 + 64 * (j))
#define XB_TOP      3328
#define XB_TOPGEN   3392
#define XCD_BAR_WORDS 3456
#define XB_SPIN_CAP (1u << 18)
__device__ __forceinline__ unsigned xb_ld(unsigned* p)              { return __hip_atomic_load(p, __ATOMIC_RELAXED, __HIP_MEMORY_SCOPE_AGENT); }
__device__ __forceinline__ unsigned xb_add(unsigned* p, unsigned v) { return __hip_atomic_fetch_add(p, v, __ATOMIC_RELAXED, __HIP_MEMORY_SCOPE_AGENT); }
__device__ __forceinline__ unsigned xb_xcc_id() { return (unsigned)__builtin_amdgcn_s_getreg((3 << 11) | 20) & 0xFu; }
#define XB_SPIN(cond, bar) do { unsigned _sp = 0; while (cond) { __builtin_amdgcn_s_sleep(1); \
    if ((++_sp & 255u) == 0u) { if (xb_ld(&(bar)[XB_TMO])) break; if (_sp > XB_SPIN_CAP) { atomicAdd(&(bar)[XB_TMO], 1u); break; } } } } while (0)
struct XcdBarrier { unsigned* bar; unsigned x; volatile LAS unsigned* st; };
__device__ __forceinline__ XcdBarrier xcd_barrier_post(unsigned* bar, volatile LAS unsigned* st) {
    XcdBarrier b; b.bar = bar; b.x = xb_xcc_id(); b.st = st;
    if (threadIdx.x == 0) (void)xb_add(&bar[XB_XCNT(b.x)], 1u);
    return b;
}
__device__ __forceinline__ void xcd_barrier_complete(unsigned* bar, unsigned x, unsigned& nloc, unsigned& nx) {
    const unsigned G = gridDim.x * gridDim.y * gridDim.z;
    unsigned sum, cnt, mine, sp = 0u;
    for (;;) {
        sum = 0u; cnt = 0u; mine = 0u;
#pragma unroll
        for (unsigned j = 0; j < 16; ++j) { const unsigned c = xb_ld(&bar[XB_XCNT(j)]); sum += c; cnt += (c > 0u) ? 1u : 0u; mine = (j == x) ? c : mine; }
        if (sum == G) break;
        __builtin_amdgcn_s_sleep(1);
        if ((++sp & 255u) == 0u) { if (xb_ld(&bar[XB_TMO])) break; if (sp > XB_SPIN_CAP) { atomicAdd(&bar[XB_TMO], 1u); break; } }
    }
    nloc = mine > 0u ? mine : 1u; nx = cnt > 0u ? cnt : 1u;
}
__device__ __forceinline__ void xcd_barrier(const XcdBarrier& b) {
    asm volatile("s_waitcnt vmcnt(0)" ::: "memory");
    __syncthreads();
    if (threadIdx.x == 0) {
        unsigned* bar = b.bar;
        __builtin_amdgcn_s_waitcnt(0);
        unsigned nloc = b.st[0], nx = b.st[1];
        if (nloc == 0u) { xcd_barrier_complete(bar, b.x, nloc, nx); b.st[0] = nloc; b.st[1] = nx; }
        const unsigned old = xb_add(&bar[XB_XSUB(b.x)], 1u);
        const unsigned gen = old / nloc;
        if (old + 1u == (gen + 1u) * nloc) {
            __builtin_amdgcn_fence(__ATOMIC_RELEASE, "agent");
            asm volatile("s_waitcnt vmcnt(0)" ::: "memory");
            const unsigned og = xb_add(&bar[XB_TOP], 1u);
            const unsigned tg = og / nx;
            if (og + 1u == (tg + 1u) * nx) xb_add(&bar[XB_TOPGEN], 1u);
            else XB_SPIN(xb_ld(&bar[XB_TOPGEN]) == tg, bar);
            __builtin_amdgcn_fence(__ATOMIC_ACQUIRE, "agent");
            xb_add(&bar[XB_XGEN(b.x)], 1u);
            asm volatile("s_waitcnt vmcnt(0)" ::: "memory");
        } else {
            XB_SPIN(xb_ld(&bar[XB_XGEN(b.x)]) == gen, bar);
            __builtin_amdgcn_fence(__ATOMIC_ACQUIRE, "agent");
            asm volatile("s_waitcnt vmcnt(0)" ::: "memory");
        }
    }
    __syncthreads();
}

constexpr int NWAVES = 8;
constexpr int RING_BYTES = 131072, LDSCTL_OFF = RING_BYTES, MISC_OFF = LDSCTL_OFF + 320, LDS_BYTES = 147456;
constexpr int CW_BAR = 4096;
constexpr int NPHASE = 13;
#ifndef MK_N_LAUNCHES
#define MK_N_LAUNCHES 13
#endif
constexpr int N_LAUNCHES = MK_N_LAUNCHES;

#define LDS_WAIT() asm volatile("s_waitcnt lgkmcnt(0)" ::: "memory")
__device__ __forceinline__ float wave_sum(float v) {
#pragma unroll
    for (int o = 1; o < 64; o <<= 1) v += __shfl_xor(v, o);
    return v;
}
__device__ __forceinline__ void p0_transpose_item(const float* W, int K, int N, bf16_t* WT, int k0, int n0, int orow0, LAS float* scr, int lane) {
#pragma unroll 8
    for (int i = 0; i < 32; ++i) { const int kk = 2 * i + (lane >> 5); scr[kk * 33 + (lane & 31)] = W[(size_t)(k0 + kk) * N + n0 + (lane & 31)]; }
    LDS_WAIT(); asm volatile("" ::: "memory");
    const int c = lane & 7;
#pragma unroll
    for (int j = 0; j < 4; ++j) { const int n = (lane >> 3) + 8 * j; const LAS float* s = scr + (8 * c) * 33 + n;
        u32x4 o; o.x = cvtpk(s[0 * 33], s[1 * 33]); o.y = cvtpk(s[2 * 33], s[3 * 33]); o.z = cvtpk(s[4 * 33], s[5 * 33]); o.w = cvtpk(s[6 * 33], s[7 * 33]);
        *(u32x4*)(WT + (size_t)(orow0 + n) * K + k0 + 8 * c) = o; }
    LDS_WAIT(); asm volatile("" ::: "memory");
}
__device__ __forceinline__ void sincos_d(double a, double& s, double& c) {
    const double k = __builtin_rint(a * 0.63661977236758134308);
    double r = __builtin_fma(-k, 1.57079632679489655800e+00, a); r = __builtin_fma(-k, 6.12323399573676603587e-17, r);
    const double r2 = r * r;
    double sp = -7.6471637318198164759e-13; sp = sp * r2 + 1.6059043836821614599e-10; sp = sp * r2 - 2.5052108385441718775e-08; sp = sp * r2 + 2.7557319223985890653e-06;
    sp = sp * r2 - 1.9841269841269841270e-04; sp = sp * r2 + 8.3333333333333333333e-03; sp = sp * r2 - 1.6666666666666666667e-01; const double sr = r + r * r2 * sp;
    double cp = 4.7794773323873852974e-14; cp = cp * r2 - 1.1470745597729724714e-11; cp = cp * r2 + 2.0876756987868098979e-09; cp = cp * r2 - 2.7557319223985890653e-07;
    cp = cp * r2 + 2.4801587301587301587e-05; cp = cp * r2 - 1.3888888888888888889e-03; cp = cp * r2 + 4.1666666666666666667e-02; cp = cp * r2 - 0.5; const double cr = 1.0 + r2 * cp;
    const int q = ((int)k) & 3;
    s = (q == 0) ? sr : (q == 1) ? cr : (q == 2) ? -sr : -cr;
    c = (q == 0) ? cr : (q == 1) ? -sr : (q == 2) ? -cr : sr;
}

struct Args { const float* in[32]; float* out; unsigned char* ws; int ph_lo, ph_hi, li, pad; };

__global__ void __launch_bounds__(NWAVES * 64, 2) mk_fwd(Args args) {
    extern __shared__ __attribute__((aligned(16))) unsigned char lds_raw[];
    LAS unsigned char* lds = (LAS unsigned char*)lds_raw;
    volatile LAS unsigned* MISC = (volatile LAS unsigned*)(lds + MISC_OFF);
    const int tid = threadIdx.x, lane = tid & 63, wave = __builtin_amdgcn_readfirstlane(tid >> 6);
    const int G = gridDim.x, bx = blockIdx.x;
    const int gw = bx * NWAVES + wave, NGW = G * NWAVES;
    unsigned char* ws = args.ws; float* out = args.out;
    gu32* ctl = (gu32*)(ws + WS_CTL);
    for (int u = tid; u < (LDS_BYTES - LDSCTL_OFF) / 4; u += NWAVES * 64) ((LAS unsigned*)(lds + LDSCTL_OFF))[u] = 0u;
    __syncthreads();
    XcdBarrier bar; bar.bar = (unsigned*)(ctl + CW_BAR); bar.x = 0; bar.st = nullptr;
    if (N_LAUNCHES == 1) bar = xcd_barrier_post((unsigned*)(ctl + CW_BAR), MISC + 8);
#define GRID_BAR() do { if (N_LAUNCHES == 1) xcd_barrier(bar); } while (0)
    const int lo = args.ph_lo, hi_ph = args.ph_hi;
#define IN(k) (lo <= (k) && (k) < hi_ph)
#define SEAM(k) do { if (IN(k) && IN((k) + 1)) GRID_BAR(); } while (0)

    const float* x_prompt = args.in[0]; const float* x_sample = args.in[1]; const float* mem_prompt = args.in[2];
    bf16_t* Wqkv_t = (bf16_t*)(ws + WS_WQKV); bf16_t* Wo_t = (bf16_t*)(ws + WS_WO); bf16_t* Wmq_t = (bf16_t*)(ws + WS_WMQ); bf16_t* Wmkv_t = (bf16_t*)(ws + WS_WMKV);
    bf16_t* Wmo_t = (bf16_t*)(ws + WS_WMO); bf16_t* Wup_t = (bf16_t*)(ws + WS_WUP); bf16_t* Wdn_t = (bf16_t*)(ws + WS_WDN);
    bf16_t* MEMB = (bf16_t*)(ws + WS_MEMB); bf16_t* MKB = (bf16_t*)(ws + WS_MKB); bf16_t* MVB = (bf16_t*)(ws + WS_MVB);
    bf16_t* KAS = (bf16_t*)(ws + WS_KAS); bf16_t* VAS = (bf16_t*)(ws + WS_VAS); bf16_t* KBS = (bf16_t*)(ws + WS_KBS); bf16_t* VBS = (bf16_t*)(ws + WS_VBS);
    bf16_t* MKS = (bf16_t*)(ws + WS_MKS); bf16_t* MVS = (bf16_t*)(ws + WS_MVS);
    bf16_t* QKVB = (bf16_t*)(ws + WS_QKVB); bf16_t* XB = (bf16_t*)(ws + WS_XB); bf16_t* OD = (bf16_t*)(ws + WS_OD); bf16_t* MIXA = (bf16_t*)(ws + WS_MIXA);
    bf16_t* X1B = (bf16_t*)(ws + WS_X1B); bf16_t* X2B = (bf16_t*)(ws + WS_X2B); bf16_t* QM = (bf16_t*)(ws + WS_QM); bf16_t* OM = (bf16_t*)(ws + WS_OM); bf16_t* HB = (bf16_t*)(ws + WS_H);
    float* ROPE = (float*)(ws + WS_ROPE); float* BT = (float*)(ws + WS_BT); float* LAMP = (float*)(ws + WS_LAM);
    float* R = out + OFF_Y;

    if (IN(0)) {
        LAS float* scr = (LAS float*)(lds + wave * 16384);
        {
            constexpr int I_QKV = 16 * 96, I_SQ = 16 * 32, I_UP = 16 * 176, I_DN = 44 * 32;
            constexpr int NITEMS = I_QKV + 5 * I_SQ + I_UP + I_DN;
            for (int it = gw; it < NITEMS; it += NGW) {
                int r = it;
                if (r < I_QKV) { const int kb = r / 96, nb = r % 96; p0_transpose_item(args.in[10], 1024, 3072, Wqkv_t, kb * 64, nb * 32, nb * 32, scr, lane); continue; } r -= I_QKV;
                if (r < I_SQ) { const int kb = r / 32, nb = r % 32; p0_transpose_item(args.in[17], 1024, 1024, Wo_t, kb * 64, nb * 32, nb * 32, scr, lane); continue; } r -= I_SQ;
                if (r < I_SQ) { const int kb = r / 32, nb = r % 32; p0_transpose_item(args.in[20], 1024, 1024, Wmq_t, kb * 64, nb * 32, nb * 32, scr, lane); continue; } r -= I_SQ;
                if (r < I_SQ) { const int kb = r / 32, nb = r % 32; p0_transpose_item(args.in[21], 1024, 1024, Wmkv_t, kb * 64, nb * 32, nb * 32, scr, lane); continue; } r -= I_SQ;
                if (r < I_SQ) { const int kb = r / 32, nb = r % 32; p0_transpose_item(args.in[22], 1024, 1024, Wmkv_t, kb * 64, nb * 32, 1024 + nb * 32, scr, lane); continue; } r -= I_SQ;
                if (r < I_SQ) { const int kb = r / 32, nb = r % 32; p0_transpose_item(args.in[23], 1024, 1024, Wmo_t, kb * 64, nb * 32, nb * 32, scr, lane); continue; } r -= I_SQ;
                if (r < I_UP) { const int kb = r / 176, nb = r % 176, n0 = nb * 32, bj = n0 / DFF, f = n0 % DFF; p0_transpose_item(args.in[26], 1024, DFF2, Wup_t, kb * 64, n0, 256 * (f / 128) + 128 * bj + (f % 128), scr, lane); continue; } r -= I_UP;
                { const int kb = r / 32, nb = r % 32; p0_transpose_item(args.in[29], DFF, 1024, Wdn_t, kb * 64, nb * 32, nb * 32, scr, lane); }
            }
        }
        for (int m = gw; m < MROWS + 256; m += NGW) {
            const float* src = (m < SEQ) ? x_prompt + (size_t)m * DM : (m < MROWS) ? x_sample + (size_t)(m - SEQ) * DM : mem_prompt + (size_t)(m - MROWS) * DM;
            bf16_t* dst = (m < MROWS) ? XB + (size_t)m * DM : MEMB + (size_t)(m - MROWS) * DM;
#pragma unroll
            for (int j = 0; j < 4; ++j) { const f32x4 v = *((const f32x4*)src + lane + 64 * j); u32x2 w; w.x = cvtpk(v[0], v[1]); w.y = cvtpk(v[2], v[3]); *((u32x2*)dst + lane + 64 * j) = w; }
        }
        {
            const int gt = bx * (NWAVES * 64) + tid, NT = G * NWAVES * 64;
            for (int i = gt; i < 8 * 512 * 128; i += NT) { const int b = i / (512 * 128), rem = i % (512 * 128);
                const f32x4 a = *((const f32x4*)args.in[3] + i), v = *((const f32x4*)args.in[4] + i); u32x2 w;
                w.x = cvtpk(a[0], a[1]); w.y = cvtpk(a[2], a[3]); *(u32x2*)(KAS + (size_t)b * 544 * 512 + (size_t)rem * 4) = w;
                w.x = cvtpk(v[0], v[1]); w.y = cvtpk(v[2], v[3]); *(u32x2*)(VAS + (size_t)b * 544 * 512 + (size_t)rem * 4) = w; }
            for (int i = gt; i < 8 * 1024 * 128; i += NT) { const int b = i / (1024 * 128), rem = i % (1024 * 128);
                const f32x4 a = *((const f32x4*)args.in[5] + i), v = *((const f32x4*)args.in[6] + i); u32x2 w;
                w.x = cvtpk(a[0], a[1]); w.y = cvtpk(a[2], a[3]); *(u32x2*)(KBS + (size_t)b * 1056 * 512 + (size_t)rem * 4) = w;
                w.x = cvtpk(v[0], v[1]); w.y = cvtpk(v[2], v[3]); *(u32x2*)(VBS + (size_t)b * 1056 * 512 + (size_t)rem * 4) = w; }
            for (int i = gt; i < 8 * 256 * 256; i += NT) {
                const f32x4 a = *((const f32x4*)args.in[7] + i), v = *((const f32x4*)args.in[8] + i); u32x2 w;
                w.x = cvtpk(a[0], a[1]); w.y = cvtpk(a[2], a[3]); *(u32x2*)(MKS + (size_t)i * 4) = w;
                w.x = cvtpk(v[0], v[1]); w.y = cvtpk(v[2], v[3]); *(u32x2*)(MVS + (size_t)i * 4) = w; }
            for (int i = gt; i < SEQ * 8; i += NT) { const int pos = i >> 3, j = i & 7;
                const double inv = (j == 0) ? 1.0 : (j == 1) ? 0.19392274474868576 : (j == 2) ? 0.03760603093086393 : (j == 3) ? 0.007292664737217109 : (j == 4) ? 0.001414213562373095 :
                                   (j == 5) ? 0.0002742481756762073 : (j == 6) ? 5.318295896944988e-05 : 1.031338537721246e-05;
                double s, c; sincos_d((double)pos * inv, s, c); ROPE[(size_t)pos * 16 + j] = (float)c; ROPE[(size_t)pos * 16 + 8 + j] = (float)s; }
            for (int i = gt; i < 8 * 640; i += NT) { const int h = i / 640, rel = (i % 640) - 63; const int cl = rel < -128 ? -128 : (rel > 128 ? 128 : rel);
                BT[i] = args.in[11][h * 257 + cl + 128] * LOG2E; }
            if (gt == 0) { float s1 = 0.f, s2 = 0.f; for (int d = 0; d < 64; ++d) { s1 += args.in[12][d] * args.in[13][d]; s2 += args.in[14][d] * args.in[15][d]; }
                LAMP[0] = expf(s1) - expf(s2) + 0.2f; }
        }
    }
    SEAM(0);
    if (IN(1)) {
        { pg8::Gemm g{XB, Wqkv_t, DM, DM, DM}; pg8::StaticOrder S; S.init(65, 12, G, bx);
          pg8::EpiQKV E{QKVB, out, ROPE, KAS, VAS, KBS, VBS};
          pg8::gemm_phase<pg8::EpiQKV, 0, true, true>(lds, g, S, E); }
        { pg8::Gemm g{MEMB, Wmkv_t, DM, DM, DM}; pg8::StaticOrder S; S.init(1, 8, G, (bx + G - 12) % G);
          pg8::EpiMemKV E{out, MKB, MVB};
          pg8::gemm_phase<pg8::EpiMemKV, 0, true, true>(lds, g, S, E); }
    }
    SEAM(1);
    if (IN(2)) {
        LAS unsigned char* wl = lds + wave * 8192;
        for (int i = 0; i * NGW < 8192; ++i) {
            const int rank = i * NGW + ((i & 1) ? (NGW - 1 - gw) : gw);
            if (rank >= 8192) continue;
            const int qblk = 511 - (rank >> 4), hmv = rank & 15, hm = hmv >> 1, vh = hmv & 1, c = qblk >> 1;
            gsa_wave<64, false>(QKVB + (size_t)(qblk * 32) * NQKV + 1536 + hm * 64, NQKV, QKVB + 2048 + hm * 64, NQKV, QKVB + 2560 + (hm >> 1) * 128 + vh * 64, NQKV, 64 * (c + 1),
                                nullptr, 0, OD + (size_t)(qblk * 32) * DM + hm * 128 + vh * 64, DM, wl, lane);
        }
        for (int u = gw; u < 4096; u += NGW) {
            const int qblk = u >> 3, h = u & 7, c = qblk >> 1, klo = (64 * c - 512) < 0 ? 0 : (64 * c - 512), nk = 64 * c + 64 - klo;
            gsa_wave<64, true>(QKVB + (size_t)(qblk * 32) * NQKV + h * 64, NQKV, QKVB + (size_t)klo * NQKV + 512 + h * 64, NQKV, QKVB + (size_t)klo * NQKV + 1024 + h * 64, NQKV, nk,
                               BT + h * 640, qblk * 32 - klo + 63, MIXA + (size_t)(qblk * 32) * DM + h * 64, DM, wl, lane);
        }
        for (int u = gw; u < 192; u += NGW) {
            if (u < 64) { const int b = u >> 3, h = u & 7;
                gsa_wave<64, true>(QKVB + (size_t)(SEQ + b * 32) * NQKV + h * 64, NQKV, KAS + (size_t)b * 544 * 512 + h * 64, 512, VAS + (size_t)b * 544 * 512 + h * 64, 512, 544,
                                   BT + h * 640, 512 + 63, MIXA + (size_t)(SEQ + b * 32) * DM + h * 64, DM, wl, lane);
            } else { const int v = u - 64, b = v >> 4, hmv = v & 15, hm = hmv >> 1, vh = hmv & 1;
                gsa_wave<64, false>(QKVB + (size_t)(SEQ + b * 32) * NQKV + 1536 + hm * 64, NQKV, KBS + (size_t)b * 1056 * 512 + hm * 64, 512, VBS + (size_t)b * 1056 * 512 + (hm >> 1) * 128 + vh * 64, 512, 1056,
                                    nullptr, 0, OD + (size_t)(SEQ + b * 32) * DM + hm * 128 + vh * 64, DM, wl, lane);
            }
        }
    }
    SEAM(2);
    if (IN(3)) {
        const float lam = LAMP[0];
        const int h = lane >> 4, d0 = (lane & 15) * 8;
        f32x4 g0 = *(const f32x4*)(args.in[16] + d0), g1 = *(const f32x4*)(args.in[16] + d0 + 4);
        for (int m = gw; m < MROWS; m += NGW) {
            const u32x4 a = *(const u32x4*)(OD + (size_t)m * DM + h * 256 + d0), b = *(const u32x4*)(OD + (size_t)m * DM + h * 256 + 128 + d0);
            float o[8]; float ss = 0.f;
#pragma unroll
            for (int j = 0; j < 4; ++j) { const unsigned ua = a[j], ub = b[j];
                o[2 * j] = __uint_as_float(ua << 16) - lam * __uint_as_float(ub << 16); o[2 * j + 1] = __uint_as_float(ua & 0xffff0000u) - lam * __uint_as_float(ub & 0xffff0000u);
                ss += o[2 * j] * o[2 * j] + o[2 * j + 1] * o[2 * j + 1]; }
            ss += __shfl_xor(ss, 1); ss += __shfl_xor(ss, 2); ss += __shfl_xor(ss, 4); ss += __shfl_xor(ss, 8);
            const float rn = 0.8f / sqrtf(ss * (1.f / 128.f) + LN_EPS);
            u32x4 w; w.x = cvtpk(o[0] * rn * g0[0], o[1] * rn * g0[1]); w.y = cvtpk(o[2] * rn * g0[2], o[3] * rn * g0[3]); w.z = cvtpk(o[4] * rn * g1[0], o[5] * rn * g1[1]); w.w = cvtpk(o[6] * rn * g1[2], o[7] * rn * g1[3]);
            *(u32x4*)(MIXA + (size_t)m * DM + 512 + h * 128 + d0) = w;
        }
    }
    SEAM(3);
    if (IN(4)) {
        pg8::Gemm g{MIXA, Wo_t, DM, DM, DM}; pg8::StaticOrder S; S.init(65, 4, G, bx);
        pg8::EpiResid E{x_prompt, x_sample, R};
        pg8::gemm_phase<pg8::EpiResid, 0, true, true>(lds, g, S, E);
    }
    SEAM(4);
#define LN_PASS(gp, bp, XO) do { \
        for (int m = gw; m < MROWS; m += NGW) { \
            f32x4* xr = (f32x4*)(R + (size_t)m * DM) + lane; f32x4 v[4]; float s = 0.f; \
            _Pragma("unroll") for (int j = 0; j < 4; ++j) { v[j] = xr[64 * j]; s += (v[j][0] + v[j][1]) + (v[j][2] + v[j][3]); } \
            const float mean = wave_sum(s) * (1.f / DM); float s2 = 0.f; \
            _Pragma("unroll") for (int j = 0; j < 4; ++j) { v[j] = v[j] - mean; s2 += (v[j][0] * v[j][0] + v[j][1] * v[j][1]) + (v[j][2] * v[j][2] + v[j][3] * v[j][3]); } \
            const float rstd = 1.f / sqrtf(wave_sum(s2) * (1.f / DM) + LN_EPS); \
            _Pragma("unroll") for (int j = 0; j < 4; ++j) { const f32x4 gg = *((const f32x4*)(gp) + lane + 64 * j), bb = *((const f32x4*)(bp) + lane + 64 * j); \
                const f32x4 y = v[j] * rstd * gg + bb; xr[64 * j] = y; \
                if (XO) { u32x2 w; w.x = cvtpk(y[0], y[1]); w.y = cvtpk(y[2], y[3]); *((u32x2*)((bf16_t*)(XO) + (size_t)m * DM) + lane + 64 * j) = w; } } \
        } } while (0)
    if (IN(5)) { LN_PASS(args.in[18], args.in[19], X1B); }
    SEAM(5);
    if (IN(6)) {
        pg8::Gemm g{X1B, Wmq_t, DM, DM, DM}; pg8::StaticOrder S; S.init(65, 4, G, bx);
        pg8::EpiBf16S E{QM, DM, C2M};
        pg8::gemm_phase<pg8::EpiBf16S, 0, true, true>(lds, g, S, E);
    }
    SEAM(6);
    if (IN(7)) {
        LAS unsigned char* wl = lds + wave * 8192;
        for (int u = gw; u < 520 * 16; u += NGW) {
            const int qblk = u >> 4, h = (u >> 2) & 3, vc = u & 3;
            const bf16_t* kk = (qblk < 512) ? MKB : MKS + (size_t)(qblk - 512) * 256 * 1024; const bf16_t* vv = (qblk < 512) ? MVB : MVS + (size_t)(qblk - 512) * 256 * 1024;
            gsa_wave<256, false>(QM + (size_t)(qblk * 32) * DM + h * 256, DM, kk + h * 256, DM, vv + h * 256 + vc * 64, DM, 256, nullptr, 0, OM + (size_t)(qblk * 32) * DM + h * 256 + vc * 64, DM, wl, lane);
        }
    }
    SEAM(7);
    if (IN(8)) {
        pg8::Gemm g{OM, Wmo_t, DM, DM, DM}; pg8::StaticOrder S; S.init(65, 4, G, bx);
        pg8::EpiResid E{R, R + (size_t)SEQ * DM, R};
        pg8::gemm_phase<pg8::EpiResid, 0, true, true>(lds, g, S, E);
    }
    SEAM(8);
    if (IN(9)) {
        if (bx == 0) { for (int i = tid; i < 1024; i += NWAVES * 64) ((unsigned*)(ws + WS_X2B - 4096))[i] = 0u; }
        LN_PASS(args.in[24], args.in[25], X2B);
    }
    SEAM(9);
    if (IN(10)) {
        { pg8::Gemm g{X2B, Wup_t, DM, DM, DM}; pg8::StaticOrder S; S.init(67, 22, G, bx);
          pg8::EpiUpConv<false> E{HB, args.in[27], args.in[28], args.in[9], out + OFF_CVP, out + OFF_CVS};
          pg8::gemm_phase<pg8::EpiUpConv<false>, 1, true, true>(lds, g, S, E); }
        { pg8::Gemm g{X2B + (size_t)SEQ * DM, Wup_t, DM, DM, DM}; pg8::StaticOrder S; S.init(1, 22, G, (bx + G - 194) % G);
          pg8::EpiUpConv<true> E{HB, args.in[27], args.in[28], args.in[9], out + OFF_CVP, out + OFF_CVS};
          pg8::gemm_phase<pg8::EpiUpConv<true>, 0, true, true>(lds, g, S, E); }
    }
    SEAM(10);
    if (IN(11)) {
        pg8::Gemm g{HB, Wdn_t, DFF, DFF, DFF}; pg8::StaticOrder S; S.init(65, 4, G, bx);
        pg8::EpiResid E{R, R + (size_t)SEQ * DM, R};
        pg8::gemm_phase<pg8::EpiResid, 0, true, true>(lds, g, S, E);
    }
    SEAM(11);
    if (IN(12)) { LN_PASS(args.in[30], args.in[31], (bf16_t*)nullptr); }
#undef IN
#undef SEAM
}

extern "C" void kernel_launch(void* const* d_in, const int* in_sizes, int n_in, void* d_out, int out_size, void* d_ws, size_t ws_size, hipStream_t stream) {
    static int grid = 0;
    if (grid == 0) {
        int dev = 0, cus = 0;
        if (hipGetDevice(&dev) != hipSuccess || hipDeviceGetAttribute(&cus, hipDeviceAttributeMultiprocessorCount, dev) != hipSuccess) { fprintf(stderr, "kernel_launch: device query failed\n"); grid = -1; return; }
        if (hipFuncSetAttribute((const void*)mk_fwd, hipFuncAttributeMaxDynamicSharedMemorySize, LDS_BYTES) != hipSuccess) { fprintf(stderr, "kernel_launch: hipFuncSetAttribute failed\n"); grid = -1; return; }
        int per_cu = 0;
        if (hipOccupancyMaxActiveBlocksPerMultiprocessor(&per_cu, (const void*)mk_fwd, NWAVES * 64, LDS_BYTES) != hipSuccess || per_cu < 1) fprintf(stderr, "kernel_launch: occupancy query reports %d\n", per_cu);
        (void)hipGetLastError();
        grid = cus;
        fprintf(stderr, "kernel_launch: grid %d, ws %zu, n_in %d, out %d\n", grid, ws_size, n_in, out_size);
    }
    if (grid < 0) return;
    (void)hipMemsetAsync((char*)d_ws + WS_CTL, 0, CTL_ZERO_BYTES, stream);
    Args a{};
    for (int i = 0; i < 32; ++i) a.in[i] = (const float*)d_in[i];
    a.out = (float*)d_out; a.ws = (unsigned char*)d_ws;
    if (N_LAUNCHES == 1) { a.ph_lo = 0; a.ph_hi = NPHASE; a.li = 0; hipLaunchKernelGGL(mk_fwd, dim3(grid), dim3(NWAVES * 64), LDS_BYTES, stream, a); }
    else for (int li = 0; li < NPHASE; ++li) { a.ph_lo = li; a.ph_hi = li + 1; a.li = li; hipLaunchKernelGGL(mk_fwd, dim3(grid), dim3(NWAVES * 64), LDS_BYTES, stream, a); }
}
```

```cpp
#include <hip/hip_runtime.h>
#include <cstdio>
#include <cstdint>

#define LAS __attribute__((address_space(3)))
#define GAS __attribute__((address_space(1)))
typedef unsigned short bf16_t;
typedef short bf16x8 __attribute__((ext_vector_type(8)));
typedef short s16x4 __attribute__((ext_vector_type(4)));
typedef float f32x2 __attribute__((ext_vector_type(2)));
typedef float f32x4 __attribute__((ext_vector_type(4)));
typedef float f32x16 __attribute__((ext_vector_type(16)));
typedef unsigned u32x2 __attribute__((ext_vector_type(2)));
typedef unsigned u32x4 __attribute__((ext_vector_type(4)));
typedef __bf16 bf16x2_t __attribute__((ext_vector_type(2)));

constexpr int DM = 1024, SEQ = 16384, NSAMP = 256, MROWS = SEQ + NSAMP;
constexpr int NQKV = 3072, DFF = 2816, DFF2 = 5632;
constexpr float LN_EPS = 1e-5f;
constexpr float ALPHA = 1.189207115002721f;
constexpr float LOG2E = 1.4426950408889634f;
constexpr float C2 = 0.125f * LOG2E;
constexpr float C2M = 0.0625f * LOG2E;
constexpr size_t OFF_Y = 0, OFF_AKP = 17039360, OFF_AVP = 17301504, OFF_BKP = 17563648, OFF_BVP = 25952256, OFF_MKP = 34340864, OFF_MVP = 34603008,
                 OFF_CVP = 34865152, OFF_AKS = 34876416, OFF_AVS = 35007488, OFF_BKS = 35138560, OFF_BVS = 35269632, OFF_CVS = 35400704;
constexpr size_t MiB = 1u << 20;
constexpr size_t WS_CTL = 0, CTL_ZERO_BYTES = 1 * MiB;
constexpr size_t WS_ROPE = 1 * MiB, WS_BT = 2 * MiB, WS_LAM = 2 * MiB + 32768;
constexpr size_t WS_WQKV = 3 * MiB, WS_WO = 9 * MiB, WS_WMQ = 11 * MiB, WS_WMKV = 13 * MiB, WS_WMO = 17 * MiB, WS_WUP = 19 * MiB, WS_WDN = 30 * MiB;
constexpr size_t WS_MEMB = 36 * MiB, WS_MKB = 36 * MiB + 512 * 1024, WS_MVB = 37 * MiB;
constexpr size_t WS_KAS = 38 * MiB, WS_VAS = 42 * MiB + 512 * 1024, WS_KBS = 47 * MiB, WS_VBS = 55 * MiB + 512 * 1024, WS_MKS = 64 * MiB, WS_MVS = 68 * MiB;
constexpr size_t WS_QKVB = 72 * MiB, WS_XB = 170 * MiB, WS_OD = 170 * MiB, WS_MIXA = 203 * MiB, WS_X1B = 203 * MiB, WS_X2B = 203 * MiB + 4096;
constexpr size_t WS_QM = 72 * MiB, WS_OM = 105 * MiB, WS_H = 72 * MiB;

__device__ __forceinline__ unsigned cvtpk(float lo, float hi) { f32x2 v = {lo, hi}; bf16x2_t b = __builtin_convertvector(v, bf16x2_t); return __builtin_bit_cast(unsigned, b); }
__device__ __forceinline__ bf16_t f2bf(float f) { return (bf16_t)(cvtpk(f, 0.f) & 0xffffu); }

namespace pg8 {
constexpr int BM = 256, BK = 64, HALF = 128, HTB = HALF * BK * 2, STAGE_BYTES = 8 * HTB, NXCD = 8, WGM = 8;
__host__ __device__ __forceinline__ int lds_byte(int r, int c) { const int st = (r >> 4) * 2 + (c >> 5), rr = r & 15, cc = c & 31, ob = rr * 64 + cc * 2; return st * 1024 + (ob ^ (((ob >> 9) & 1) << 5)); }
__host__ __device__ __forceinline__ void stage_rc(int b, int& R, int& C) { const int st = b / 1024, sb = b % 1024, swz = sb ^ (((sb >> 9) & 1) << 5); R = (st >> 1) * 16 + swz / 64; C = (st & 1) * 32 + (swz % 64) / 2; }
__host__ __device__ __forceinline__ int perm32(int rho) { const int n = rho >> 4, i = rho & 15; return 8 * (i >> 2) + 4 * n + (i & 3); }
struct Unit { int pm, pn; };
struct Gemm { const bf16_t* A; const bf16_t* Bt; int lda, ldb, K; };
struct StaticOrder {
    int nM, nN, nwg, G, c;
    __host__ __device__ void init(int nM_, int nN_, int G_, int c_) { nM = nM_; nN = nN_; nwg = nM * nN; G = G_; c = c_; }
    __host__ __device__ bool next(int i, Unit& u) const {
        const long L = (long)i * G + c; if (L >= nwg) return false;
        int wgid = (int)L; { const int q = nwg / NXCD, r = nwg % NXCD, xcd = wgid % NXCD, off = wgid / NXCD; wgid = (xcd < r ? xcd * (q + 1) : r * (q + 1) + (xcd - r) * q) + off; }
        const int nig = WGM * nN, gid = wgid / nig, fm = gid * WGM, gsz = (nM - fm) < WGM ? (nM - fm) : WGM;
        u.pm = fm + ((wgid % nig) % gsz); u.pn = (wgid % nig) / gsz; return true;
    }
};
template <class Epi, int AMODE, bool ALIGN_EPI, bool SP2>
__device__ __forceinline__ void gemm_phase(LAS unsigned char* lds, const Gemm g, const StaticOrder& S, const Epi& E) {
    const int tid = threadIdx.x, wid = __builtin_amdgcn_readfirstlane(tid >> 6), lane = tid & 63, wr = wid >> 2, wc = wid & 3, fr = lane & 15, fq = lane >> 4;
    const int K = g.K, nt = K / BK;
    unsigned voffA[2], voffB[2];
#pragma unroll
    for (int i = 0; i < 2; ++i) { int R, C; stage_rc(tid * 16 + i * 8192, R, C); const int Rb = Epi::PERM ? ((R & ~31) + perm32(R & 31)) : R;
        const int Ra = (AMODE == 1) ? (62 * (R >> 6) + (R & 63)) : R;
        voffA[i] = (unsigned)(Ra * g.lda + C) * 2u; voffB[i] = (unsigned)(Rb * g.ldb + C) * 2u; }
    const size_t kstep = (size_t)(BK * 2);
    const size_t hstepA = (size_t)((AMODE == 1) ? 124 : 128) * g.lda * 2, hstepB = (size_t)HALF * g.ldb * 2;
    const unsigned ldsw = (unsigned)wid * 1024u;
    const int aoff = lds_byte(wr * 64 + fr, fq * 8), boff = lds_byte(wc * 32 + fr, fq * 8);
#define PG8_TILEA(pm) ((const char*)g.A + (ptrdiff_t)((AMODE == 1) ? (248 * (pm) - 2) : (256 * (pm))) * g.lda * 2)
#define PG8_TILEB(pn) ((const char*)g.Bt + (size_t)(256 * (pn)) * g.ldb * 2)
#define PG8_SA(b, h) (((b) * 2 + (h)) * HTB)
#define PG8_SB(b, h) ((4 + (b) * 2 + (h)) * HTB)
#define PG8_STAGE(bufoff, gbase, voff) do { _Pragma("unroll") for (int _i = 0; _i < 2; ++_i) \
        __builtin_amdgcn_global_load_lds((const unsigned*)((const char*)(gbase) + (voff)[_i]), (LAS unsigned*)(lds + (bufoff) + ldsw + _i * 8192), 16, 0, 0); } while (0)
#define PG8_LDA(dst, b, h) do { _Pragma("unroll") for (int m = 0; m < 4; ++m) _Pragma("unroll") for (int k = 0; k < 2; ++k) dst[m][k] = *(const LAS bf16x8*)(lds + PG8_SA(b, h) + aoff + m * 2048 + k * 1024); } while (0)
#define PG8_LDB(dst, b, h) do { _Pragma("unroll") for (int n = 0; n < 2; ++n) _Pragma("unroll") for (int k = 0; k < 2; ++k) dst[n][k] = *(const LAS bf16x8*)(lds + PG8_SB(b, h) + boff + n * 2048 + k * 1024); } while (0)
#define PG8_MMA(ai, bj, At, Bt) do { __builtin_amdgcn_s_setprio(1); _Pragma("unroll") for (int m = 0; m < 4; ++m) _Pragma("unroll") for (int n = 0; n < 2; ++n) _Pragma("unroll") for (int k = 0; k < 2; ++k) \
        acc[ai][bj][m][n] = __builtin_amdgcn_mfma_f32_16x16x32_bf16(Bt[n][k], At[m][k], acc[ai][bj][m][n], 0, 0, 0); __builtin_amdgcn_s_setprio(0); } while (0)
#define PG8_WAIT_V(n) asm volatile("s_waitcnt vmcnt(" #n ")" ::: "memory")
#define PG8_WAIT_L(n) asm volatile("s_waitcnt lgkmcnt(" #n ")" ::: "memory")
#define PG8_BAR __builtin_amdgcn_s_barrier()
#define PG8_SCHED __builtin_amdgcn_sched_barrier(0)
    Unit cur, nxt; int ui = 0;
    if (!S.next(0, cur)) return;
    f32x4 acc[2][2][4][2];
#pragma unroll
    for (int a = 0; a < 2; ++a)
#pragma unroll
        for (int b = 0; b < 2; ++b)
#pragma unroll
            for (int m = 0; m < 4; ++m)
#pragma unroll
                for (int n = 0; n < 2; ++n) acc[a][b][m][n] = (f32x4){0.f, 0.f, 0.f, 0.f};
    bf16x8 At[4][2], B0[2][2], B1[2][2];
    const char* cA = PG8_TILEA(cur.pm); const char* cB = PG8_TILEB(cur.pn);
    if constexpr (SP2) {
        PG8_STAGE(PG8_SB(0, 0), cB, voffB); PG8_STAGE(PG8_SB(0, 1), cB + hstepB, voffB); PG8_STAGE(PG8_SA(0, 0), cA, voffA); PG8_STAGE(PG8_SA(0, 1), cA + hstepA, voffA);
        if (wr == 1) PG8_BAR;
        PG8_WAIT_V(2); PG8_BAR;
        PG8_STAGE(PG8_SB(1, 0), cB + kstep, voffB); PG8_STAGE(PG8_SA(1, 0), cA + kstep, voffA); PG8_STAGE(PG8_SB(1, 1), cB + hstepB + kstep, voffB);
        PG8_WAIT_V(6); PG8_BAR;
    } else {
        PG8_STAGE(PG8_SB(0, 0), cB, voffB); PG8_STAGE(PG8_SA(0, 0), cA, voffA); PG8_STAGE(PG8_SB(0, 1), cB + hstepB, voffB); PG8_STAGE(PG8_SA(0, 1), cA + hstepA, voffA);
        if (wr == 1) PG8_BAR;
        PG8_WAIT_V(4); PG8_BAR;
        PG8_STAGE(PG8_SB(1, 0), cB + kstep, voffB); PG8_STAGE(PG8_SA(1, 0), cA + kstep, voffA); PG8_STAGE(PG8_SB(1, 1), cB + hstepB + kstep, voffB);
        PG8_WAIT_V(6); PG8_BAR;
    }
    for (;;) {
        const bool has_next = S.next(ui + 1, nxt);
        const char* nA = has_next ? PG8_TILEA(nxt.pm) : cA; const char* nB = has_next ? PG8_TILEB(nxt.pn) : cB;
        for (int t = 0; t < nt; t += 2) {
            const bool last = (t == nt - 2);
            const char* a1 = cA + (size_t)(t + 1) * kstep;
            const char* a2 = last ? nA : cA + (size_t)(t + 2) * kstep; const char* b2 = last ? nB : cB + (size_t)(t + 2) * kstep;
            const char* a3 = a2 + kstep; const char* b3 = b2 + kstep;
            if constexpr (SP2) {
            PG8_LDB(B0, 0, 0); PG8_LDB(B1, 0, 1); PG8_SCHED; PG8_LDA(At, 0, 0); PG8_STAGE(PG8_SA(1, 1), a1 + hstepA, voffA);
            PG8_WAIT_V(8); PG8_WAIT_L(0); PG8_BAR; PG8_MMA(0, 0, At, B0); PG8_MMA(0, 1, At, B1); PG8_BAR; PG8_SCHED;
            PG8_LDA(At, 0, 1); PG8_STAGE(PG8_SB(0, 0), b2, voffB); PG8_STAGE(PG8_SB(0, 1), b2 + hstepB, voffB); PG8_STAGE(PG8_SA(0, 0), a2, voffA);
            PG8_WAIT_V(8); PG8_WAIT_L(0); PG8_BAR; PG8_MMA(1, 0, At, B0); PG8_MMA(1, 1, At, B1); PG8_BAR; PG8_SCHED;
            PG8_LDB(B0, 1, 0); PG8_LDB(B1, 1, 1); PG8_SCHED; PG8_LDA(At, 1, 0); PG8_STAGE(PG8_SA(0, 1), a2 + hstepA, voffA);
            PG8_WAIT_V(8); PG8_WAIT_L(0); PG8_BAR; PG8_MMA(0, 0, At, B0); PG8_MMA(0, 1, At, B1); PG8_BAR; PG8_SCHED;
            PG8_LDA(At, 1, 1); PG8_STAGE(PG8_SB(1, 0), b3, voffB); PG8_STAGE(PG8_SB(1, 1), b3 + hstepB, voffB); PG8_STAGE(PG8_SA(1, 0), a3, voffA);
            PG8_WAIT_V(8); PG8_WAIT_L(0); PG8_BAR; PG8_MMA(1, 0, At, B0); PG8_MMA(1, 1, At, B1); PG8_BAR; PG8_SCHED;
            } else {
            PG8_LDB(B0, 0, 0); PG8_SCHED; PG8_LDA(At, 0, 0); PG8_STAGE(PG8_SA(1, 1), a1 + hstepA, voffA);
            PG8_WAIT_L(8); PG8_BAR; PG8_WAIT_L(0); PG8_MMA(0, 0, At, B0); PG8_BAR; PG8_SCHED;
            PG8_LDB(B1, 0, 1); PG8_STAGE(PG8_SB(0, 0), b2, voffB);
            PG8_BAR; PG8_WAIT_L(0); PG8_MMA(0, 1, At, B1); PG8_BAR;
            PG8_LDA(At, 0, 1); PG8_STAGE(PG8_SA(0, 0), a2, voffA);
            PG8_BAR; PG8_WAIT_L(0); PG8_MMA(1, 0, At, B0); PG8_BAR; PG8_SCHED;
            PG8_STAGE(PG8_SB(0, 1), b2 + hstepB, voffB);
            PG8_WAIT_V(6); PG8_BAR; PG8_MMA(1, 1, At, B1); PG8_BAR;
            PG8_LDB(B0, 1, 0); PG8_SCHED; PG8_LDA(At, 1, 0); PG8_STAGE(PG8_SA(0, 1), a2 + hstepA, voffA);
            PG8_WAIT_L(8); PG8_BAR; PG8_WAIT_L(0); PG8_MMA(0, 0, At, B0); PG8_BAR; PG8_SCHED;
            PG8_LDB(B1, 1, 1); PG8_STAGE(PG8_SB(1, 0), b3, voffB);
            PG8_BAR; PG8_WAIT_L(0); PG8_MMA(0, 1, At, B1); PG8_BAR;
            PG8_LDA(At, 1, 1); PG8_STAGE(PG8_SA(1, 0), a3, voffA);
            PG8_BAR; PG8_WAIT_L(0); PG8_MMA(1, 0, At, B0); PG8_BAR; PG8_SCHED;
            PG8_STAGE(PG8_SB(1, 1), b3 + hstepB, voffB);
            PG8_WAIT_V(6); PG8_BAR; PG8_MMA(1, 1, At, B1); PG8_BAR;
            }
        }
        if constexpr (ALIGN_EPI) { if (wr == 0) PG8_BAR; }
        E(acc, cur, wr, wc, fr, fq);
        if (!has_next) break;
#pragma unroll
        for (int a = 0; a < 2; ++a)
#pragma unroll
            for (int b = 0; b < 2; ++b)
#pragma unroll
                for (int m = 0; m < 4; ++m)
#pragma unroll
                    for (int n = 0; n < 2; ++n) acc[a][b][m][n] = (f32x4){0.f, 0.f, 0.f, 0.f};
        cur = nxt; cA = nA; cB = nB; ++ui;
        if constexpr (ALIGN_EPI) { if (wr == 1) PG8_BAR; }
    }
    PG8_WAIT_V(0);
    if constexpr (!ALIGN_EPI) { if (wr == 0) PG8_BAR; }
    PG8_BAR;
#undef PG8_TILEA
#undef PG8_TILEB
#undef PG8_SA
#undef PG8_SB
#undef PG8_STAGE
#undef PG8_LDA
#undef PG8_LDB
#undef PG8_MMA
#undef PG8_WAIT_V
#undef PG8_WAIT_L
#undef PG8_BAR
#undef PG8_SCHED
}

struct EpiQKV {
    static constexpr bool PERM = true;
    bf16_t* qkvb; float* out; const float* rope; bf16_t *kas, *vas, *kbs, *vbs;
    __device__ __forceinline__ void operator()(const f32x4 (&acc)[2][2][4][2], const Unit& u, int wr, int wc, int fr, int fq) const {
        const int pn = u.pn, pm = u.pm, region = pn >> 1;
        const bool isq = (region == 0) || (region == 3);
        const float sc = isq ? C2 : 1.f;
        const bool rope_on = (pn >= 6 && pn < 10) && ((wc & 1) == 0);
#pragma unroll
        for (int ai = 0; ai < 2; ++ai)
#pragma unroll
            for (int m = 0; m < 4; ++m) {
                const int lr = ai * 128 + wr * 64 + m * 16 + fr, grow = pm * 256 + lr;
                f32x4 cs0 = {1.f, 1.f, 1.f, 1.f}, cs1 = cs0, sn0 = {0.f, 0.f, 0.f, 0.f}, sn1 = sn0;
                if (rope_on) { const int pos = (grow < SEQ) ? grow : 1024 + ((grow - SEQ) & 31); const f32x4* rp = (const f32x4*)(rope + (size_t)pos * 16);
                    cs0 = rp[0]; cs1 = rp[1]; sn0 = rp[2]; sn1 = rp[3]; }
#pragma unroll
                for (int bj = 0; bj < 2; ++bj) {
                    f32x4 v0 = acc[ai][bj][m][0], v1 = acc[ai][bj][m][1];
                    const int c8 = pn * 256 + bj * 128 + wc * 32 + fq * 8, cr = c8 - region * 512;
                    if (rope_on) {
                        f32x4 p0, p1;
#pragma unroll
                        for (int j = 0; j < 4; ++j) { p0[j] = __shfl_xor(v0[j], 16); p1[j] = __shfl_xor(v1[j], 16); }
                        if (fq == 0) { v0 = v0 * cs0 - p0 * sn0; v1 = v1 * cs1 - p1 * sn1; }
                        else if (fq == 1) { v0 = v0 * cs0 + p0 * sn0; v1 = v1 * cs1 + p1 * sn1; }
                    }
                    float* fo = nullptr;
                    if (region == 1 || region == 2) {
                        if (pm == 64) fo = out + (region == 1 ? OFF_AKS : OFF_AVS) + (size_t)(grow - SEQ) * 512 + cr;
                        else if (grow >= SEQ - 512) fo = out + (region == 1 ? OFF_AKP : OFF_AVP) + (size_t)(grow - (SEQ - 512)) * 512 + cr;
                    } else if (region == 4 || region == 5) {
                        if (pm == 64) fo = out + (region == 4 ? OFF_BKS : OFF_BVS) + (size_t)(grow - SEQ) * 512 + cr;
                        else fo = out + (region == 4 ? OFF_BKP : OFF_BVP) + (size_t)grow * 512 + cr;
                    }
                    if (fo) { *(f32x4*)fo = v0; *(f32x4*)(fo + 4) = v1; }
                    u32x4 w; w.x = cvtpk(v0[0] * sc, v0[1] * sc); w.y = cvtpk(v0[2] * sc, v0[3] * sc); w.z = cvtpk(v1[0] * sc, v1[1] * sc); w.w = cvtpk(v1[2] * sc, v1[3] * sc);
                    *(u32x4*)(qkvb + (size_t)grow * NQKV + c8) = w;
                    if (pm == 64) { const int b = (grow - SEQ) >> 5, t = (grow - SEQ) & 31;
                        if (region == 1) *(u32x4*)(kas + ((size_t)(b * 544 + 512 + t)) * 512 + cr) = w;
                        else if (region == 2) *(u32x4*)(vas + ((size_t)(b * 544 + 512 + t)) * 512 + cr) = w;
                        else if (region == 4) *(u32x4*)(kbs + ((size_t)(b * 1056 + 1024 + t)) * 512 + cr) = w;
                        else if (region == 5) *(u32x4*)(vbs + ((size_t)(b * 1056 + 1024 + t)) * 512 + cr) = w; }
                }
            }
    }
};
struct EpiMemKV {
    static constexpr bool PERM = true;
    float* out; bf16_t *mkb, *mvb;
    __device__ __forceinline__ void operator()(const f32x4 (&acc)[2][2][4][2], const Unit& u, int wr, int wc, int fr, int fq) const {
        const bool isv = u.pn >= 4;
        float* fb = out + (isv ? OFF_MVP : OFF_MKP); bf16_t* bb = isv ? mvb : mkb;
#pragma unroll
        for (int ai = 0; ai < 2; ++ai)
#pragma unroll
            for (int m = 0; m < 4; ++m) { const int lr = ai * 128 + wr * 64 + m * 16 + fr;
#pragma unroll
                for (int bj = 0; bj < 2; ++bj) { const f32x4 v0 = acc[ai][bj][m][0], v1 = acc[ai][bj][m][1];
                    const int c8 = (u.pn & 3) * 256 + bj * 128 + wc * 32 + fq * 8;
                    *(f32x4*)(fb + (size_t)lr * 1024 + c8) = v0; *(f32x4*)(fb + (size_t)lr * 1024 + c8 + 4) = v1;
                    u32x4 w; w.x = cvtpk(v0[0], v0[1]); w.y = cvtpk(v0[2], v0[3]); w.z = cvtpk(v1[0], v1[1]); w.w = cvtpk(v1[2], v1[3]);
                    *(u32x4*)(bb + (size_t)lr * 1024 + c8) = w; } }
    }
};
struct EpiResid {
    static constexpr bool PERM = false;
    const float* base0; const float* base1; float* out;
    __device__ __forceinline__ void operator()(const f32x4 (&acc)[2][2][4][2], const Unit& u, int wr, int wc, int fr, int fq) const {
#pragma unroll
        for (int ai = 0; ai < 2; ++ai)
#pragma unroll
            for (int m = 0; m < 4; ++m) { const int grow = u.pm * 256 + ai * 128 + wr * 64 + m * 16 + fr;
                const float* bp = (u.pm < 64) ? base0 + (size_t)grow * DM : base1 + (size_t)(grow - SEQ) * DM; float* op = out + (size_t)grow * DM;
#pragma unroll
                for (int bj = 0; bj < 2; ++bj)
#pragma unroll
                    for (int n = 0; n < 2; ++n) { const int col = u.pn * 256 + bj * 128 + wc * 32 + n * 16 + fq * 4;
                        const f32x4 b = *(const f32x4*)(bp + col); *(f32x4*)(op + col) = b * ALPHA + acc[ai][bj][m][n]; } }
    }
};
struct EpiBf16S {
    static constexpr bool PERM = true;
    bf16_t* O; int ldc; float scale;
    __device__ __forceinline__ void operator()(const f32x4 (&acc)[2][2][4][2], const Unit& u, int wr, int wc, int fr, int fq) const {
#pragma unroll
        for (int ai = 0; ai < 2; ++ai)
#pragma unroll
            for (int m = 0; m < 4; ++m) { const int grow = u.pm * 256 + ai * 128 + wr * 64 + m * 16 + fr;
#pragma unroll
                for (int bj = 0; bj < 2; ++bj) { const f32x4 v0 = acc[ai][bj][m][0] * scale, v1 = acc[ai][bj][m][1] * scale;
                    const int c8 = u.pn * 256 + bj * 128 + wc * 32 + fq * 8;
                    u32x4 w; w.x = cvtpk(v0[0], v0[1]); w.y = cvtpk(v0[2], v0[3]); w.z = cvtpk(v1[0], v1[1]); w.w = cvtpk(v1[2], v1[3]);
                    *(u32x4*)(O + (size_t)grow * ldc + c8) = w; } }
    }
};
template <bool SAMPLE> struct EpiUpConv {
    static constexpr bool PERM = true;
    bf16_t* H; const float* cw; const float* cb; const float* state; float* convp; float* convs;
    __device__ __forceinline__ void operator()(const f32x4 (&acc)[2][2][4][2], const Unit& u, int wr, int wc, int fr, int fq) const {
        const int lane = threadIdx.x & 63;
        const int src1 = (lane & 48) | ((lane - 1) & 15), src2 = (lane & 48) | ((lane - 2) & 15);
#pragma unroll
        for (int n = 0; n < 2; ++n) {
            const int gcol = u.pn * 128 + wc * 32 + fq * 8 + 4 * n;
            const f32x4 w0g = *(const f32x4*)(cw + gcol), w1g = *(const f32x4*)(cw + DFF2 + gcol), w2g = *(const f32x4*)(cw + 2 * DFF2 + gcol), bg = *(const f32x4*)(cb + gcol);
            const f32x4 w0v = *(const f32x4*)(cw + DFF + gcol), w1v = *(const f32x4*)(cw + DFF2 + DFF + gcol), w2v = *(const f32x4*)(cw + 2 * DFF2 + DFF + gcol), bv = *(const f32x4*)(cb + DFF + gcol);
#pragma unroll
            for (int ai = 0; ai < 2; ++ai)
#pragma unroll
                for (int m = 0; m < 4; ++m) {
                    const int lr = ai * 128 + wr * 64 + m * 16 + fr, rho = m * 16 + fr;
                    const f32x4 ug = acc[ai][0][m][n], uv = acc[ai][1][m][n];
                    const f32x4 pg = (m > 0) ? acc[ai][0][m - 1][n] : ug, pv = (m > 0) ? acc[ai][1][m - 1][n] : uv;
                    f32x4 t1g, t2g, t1v, t2v, p1g, p2g, p1v, p2v;
#pragma unroll
                    for (int j = 0; j < 4; ++j) { t1g[j] = (fr == 15) ? pg[j] : ug[j]; t2g[j] = (fr >= 14) ? pg[j] : ug[j]; t1v[j] = (fr == 15) ? pv[j] : uv[j]; t2v[j] = (fr >= 14) ? pv[j] : uv[j]; }
#pragma unroll
                    for (int j = 0; j < 4; ++j) { p1g[j] = __shfl(t1g[j], src1); p2g[j] = __shfl(t2g[j], src2); p1v[j] = __shfl(t1v[j], src1); p2v[j] = __shfl(t2v[j], src2); }
                    int grow; bool valid;
                    if (SAMPLE) {
                        grow = SEQ + lr; valid = true;
                        if ((m & 1) == 0) {
                            const int b = lr >> 5;
                            if (fr < 2) { const float* s0 = state + (size_t)(b * 2) * DFF2 + gcol; const float* s1 = s0 + DFF2;
                                const f32x4 s0g = *(const f32x4*)s0, s1g = *(const f32x4*)s1, s0v = *(const f32x4*)(s0 + DFF), s1v = *(const f32x4*)(s1 + DFF);
                                if (fr == 0) { p1g = s1g; p2g = s0g; p1v = s1v; p2v = s0v; } else { p2g = s1g; p2v = s1v; } }
                        }
                        const int t = lr & 31;
                        if (t >= 30) { float* cp = convs + (size_t)((lr >> 5) * 2 + (t - 30)) * DFF2 + gcol; *(f32x4*)cp = ug; *(f32x4*)(cp + DFF) = uv; }
                    } else {
                        grow = 62 * (4 * u.pm + 2 * ai + wr) + rho - 2; valid = (rho >= 2) && (grow < SEQ);
                        if (valid && grow >= SEQ - 2) { float* cp = convp + (size_t)(grow - (SEQ - 2)) * DFF2 + gcol; *(f32x4*)cp = ug; *(f32x4*)(cp + DFF) = uv; }
                    }
                    const f32x4 cg = w2g * ug + w1g * p1g + w0g * p2g + bg, cv = w2v * uv + w1v * p1v + w0v * p2v + bv;
                    f32x4 h;
#pragma unroll
                    for (int j = 0; j < 4; ++j) h[j] = cg[j] * __builtin_amdgcn_rcpf(1.f + __builtin_amdgcn_exp2f(-LOG2E * cg[j])) * cv[j];
                    if (valid) { u32x2 w; w.x = cvtpk(h[0], h[1]); w.y = cvtpk(h[2], h[3]); *(u32x2*)(H + (size_t)grow * DFF + gcol) = w; }
                }
        }
    }
};
}

__device__ __forceinline__ int crow(int r, int hi) { return (r & 3) + 8 * (r >> 2) + 4 * hi; }
typedef short v4i16_t __attribute__((ext_vector_type(4)));
__device__ __forceinline__ s16x4 vtr(const LAS unsigned char* p) { return __builtin_bit_cast(s16x4, __builtin_amdgcn_ds_read_tr16_b64_v4i16((LAS v4i16_t*)p)); }
template <int DQ, bool BIAS>
__device__ __forceinline__ void gsa_wave(const bf16_t* Q, int qp, const bf16_t* K, int kp, const bf16_t* V, int vp, int nkeys, const float* btab, int relbase,
                                         bf16_t* O, int op, LAS unsigned char* wl, int lane) {
    const int r32 = lane & 31, hi = lane >> 5;
    LAS float* wsf = (LAS float*)(wl + 4096);
    bf16x8 qr[DQ / 16];
#pragma unroll
    for (int d0 = 0; d0 < DQ / 16; ++d0) qr[d0] = *(const bf16x8*)(Q + (size_t)r32 * qp + d0 * 16 + hi * 8);
    f32x16 o0 = {}, o1 = {};
    float mrun = -INFINITY, l = 0.f;
    const LAS unsigned char* vb = wl + (4 * hi + ((lane & 15) >> 2)) * 64 + ((lane >> 4) & 1) * 32 + (lane & 3) * 8;
    for (int k0 = 0; k0 < nkeys; k0 += 32) {
        u32x4 vreg[4];
#pragma unroll
        for (int i = 0; i < 4; ++i) { const int idx = i * 64 + lane, key = idx >> 3, ch = idx & 7; vreg[i] = *(const u32x4*)(V + (size_t)(k0 + key) * vp + ch * 8); }
        f32x16 s = {};
#pragma unroll
        for (int d0 = 0; d0 < DQ / 16; ++d0) { const bf16x8 kf = *(const bf16x8*)(K + (size_t)(k0 + r32) * kp + d0 * 16 + hi * 8); s = __builtin_amdgcn_mfma_f32_32x32x16_bf16(kf, qr[d0], s, 0, 0, 0); }
#pragma unroll
        for (int i = 0; i < 4; ++i) { const int idx = i * 64 + lane, key = idx >> 3, ch = idx & 7; *(LAS u32x4*)(wl + ((ch >> 2) * 2 + (key >> 4)) * 1024 + (key & 15) * 64 + (ch & 3) * 16) = vreg[i]; }
        if (BIAS) {
#pragma unroll
            for (int r = 0; r < 16; ++r) s[r] += btab[relbase + r32 - (k0 + crow(r, hi))];
        }
        float mx = s[0];
#pragma unroll
        for (int r = 1; r < 16; ++r) mx = fmaxf(mx, s[r]);
        mx = fmaxf(mx, __shfl_xor(mx, 32));
        const float mnew = fmaxf(mrun, mx), alpha = __builtin_amdgcn_exp2f(mrun - mnew);
        float rs = 0.f;
#pragma unroll
        for (int r = 0; r < 16; ++r) { s[r] = __builtin_amdgcn_exp2f(s[r] - mnew); rs += s[r]; }
        rs += __shfl_xor(rs, 32);
        l = l * alpha + rs; mrun = mnew;
        if (hi == 0) wsf[r32] = alpha;
        asm volatile("s_waitcnt lgkmcnt(0)" ::: "memory");
#pragma unroll
        for (int g = 0; g < 4; ++g) { const f32x4 a4 = *(const LAS f32x4*)(wsf + 8 * g + 4 * hi);
#pragma unroll
            for (int j = 0; j < 4; ++j) { o0[4 * g + j] *= a4[j]; o1[4 * g + j] *= a4[j]; } }
        u32x4 pw0, pw1;
        pw0.x = cvtpk(s[0], s[1]); pw0.y = cvtpk(s[2], s[3]); pw0.z = cvtpk(s[4], s[5]); pw0.w = cvtpk(s[6], s[7]);
        pw1.x = cvtpk(s[8], s[9]); pw1.y = cvtpk(s[10], s[11]); pw1.z = cvtpk(s[12], s[13]); pw1.w = cvtpk(s[14], s[15]);
#pragma unroll
        for (int d0 = 0; d0 < 2; ++d0)
#pragma unroll
            for (int ks = 0; ks < 2; ++ks) {
                const s16x4 lo = vtr(vb + (d0 * 2 + ks) * 1024), hh = vtr(vb + (d0 * 2 + ks) * 1024 + 512);
                const bf16x8 vf = {lo[0], lo[1], lo[2], lo[3], hh[0], hh[1], hh[2], hh[3]};
                const bf16x8 pa = __builtin_bit_cast(bf16x8, ks == 0 ? pw0 : pw1);
                if (d0 == 0) o0 = __builtin_amdgcn_mfma_f32_32x32x16_bf16(pa, vf, o0, 0, 0, 0); else o1 = __builtin_amdgcn_mfma_f32_32x32x16_bf16(pa, vf, o1, 0, 0, 0);
            }
        asm volatile("s_waitcnt lgkmcnt(0)" ::: "memory");
    }
    if (hi == 0) wsf[r32] = 1.f / l;
    asm volatile("s_waitcnt lgkmcnt(0)" ::: "memory");
#pragma unroll
    for (int r = 0; r < 16; ++r) { const int q = crow(r, hi); const float rl = wsf[q];
        O[(size_t)q * op + r32] = f2bf(o0[r] * rl); O[(size_t)q * op + 32 + r32] = f2bf(o1[r] * rl); }
    asm volatile("s_waitcnt lgkmcnt(0)" ::: "memory");
}

typedef GAS unsigned gu32;
#define RLX_AGENT __ATOMIC_RELAXED, __HIP_MEMORY_SCOPE_AGENT
#define XB_TMO      128
#define XB_XCNT(j)  (256  + 64 * (j))
#define XB_XSUB(j)  (1280 + 64 * (j))
#define XB_XGEN(j)  (2304 + 64 * (j))
#define XB_TOP      3328
#define XB_TOPGEN   3392
#define XCD_BAR_WORDS 3456
#define XB_SPIN_CAP (1u << 18)
__device__ __forceinline__ unsigned xb_ld(unsigned* p)              { return __hip_atomic_load(p, __ATOMIC_RELAXED, __HIP_MEMORY_SCOPE_AGENT); }
__device__ __forceinline__ unsigned xb_add(unsigned* p, unsigned v) { return __hip_atomic_fetch_add(p, v, __ATOMIC_RELAXED, __HIP_MEMORY_SCOPE_AGENT); }
__device__ __forceinline__ unsigned xb_xcc_id() { return (unsigned)__builtin_amdgcn_s_getreg((3 << 11) | 20) & 0xFu; }
#define XB_SPIN(cond, bar) do { unsigned _sp = 0; while (cond) { __builtin_amdgcn_s_sleep(1); \
    if ((++_sp & 255u) == 0u) { if (xb_ld(&(bar)[XB_TMO])) break; if (_sp > XB_SPIN_CAP) { atomicAdd(&(bar)[XB_TMO], 1u); break; } } } } while (0)
struct XcdBarrier { unsigned* bar; unsigned x; volatile LAS unsigned* st; };
__device__ __forceinline__ XcdBarrier xcd_barrier_post(unsigned* bar, volatile LAS unsigned* st) {
    XcdBarrier b; b.bar = bar; b.x = xb_xcc_id(); b.st = st;
    if (threadIdx.x == 0) (void)xb_add(&bar[XB_XCNT(b.x)], 1u);
    return b;
}
__device__ __forceinline__ void xcd_barrier_complete(unsigned* bar, unsigned x, unsigned& nloc, unsigned& nx) {
    const unsigned G = gridDim.x * gridDim.y * gridDim.z;
    unsigned sum, cnt, mine, sp = 0u;
    for (;;) {
        sum = 0u; cnt = 0u; mine = 0u;
#pragma unroll
        for (unsigned j = 0; j < 16; ++j) { const unsigned c = xb_ld(&bar[XB_XCNT(j)]); sum += c; cnt += (c > 0u) ? 1u : 0u; mine = (j == x) ? c : mine; }
        if (sum == G) break;
        __builtin_amdgcn_s_sleep(1);
        if ((++sp & 255u) == 0u) { if (xb_ld(&bar[XB_TMO])) break; if (sp > XB_SPIN_CAP) { atomicAdd(&bar[XB_TMO], 1u); break; } }
    }
    nloc = mine > 0u ? mine : 1u; nx = cnt > 0u ? cnt : 1u;
}
__device__ __forceinline__ void xcd_barrier(const XcdBarrier& b) {
    asm volatile("s_waitcnt vmcnt(0)" ::: "memory");
    __syncthreads();
    if (threadIdx.x == 0) {
        unsigned* bar = b.bar;
        __builtin_amdgcn_s_waitcnt(0);
        unsigned nloc = b.st[0], nx = b.st[1];
        if (nloc == 0u) { xcd_barrier_complete(bar, b.x, nloc, nx); b.st[0] = nloc; b.st[1] = nx; }
        const unsigned old = xb_add(&bar[XB_XSUB(b.x)], 1u);
        const unsigned gen = old / nloc;
        if (old + 1u == (gen + 1u) * nloc) {
            __builtin_amdgcn_fence(__ATOMIC_RELEASE, "agent");
            asm volatile("s_waitcnt vmcnt(0)" ::: "memory");
            const unsigned og = xb_add(&bar[XB_TOP], 1u);
            const unsigned tg = og / nx;
            if (og + 1u == (tg + 1u) * nx) xb_add(&bar[XB_TOPGEN], 1u);
            else XB_SPIN(xb_ld(&bar[XB_TOPGEN]) == tg, bar);
            __builtin_amdgcn_fence(__ATOMIC_ACQUIRE, "agent");
            xb_add(&bar[XB_XGEN(b.x)], 1u);
            asm volatile("s_waitcnt vmcnt(0)" ::: "memory");
        } else {
            XB_SPIN(xb_ld(&bar[XB_XGEN(b.x)]) == gen, bar);
            __builtin_amdgcn_fence(__ATOMIC_ACQUIRE, "agent");
            asm volatile("s_waitcnt vmcnt(0)" ::: "memory");
        }
    }
    __syncthreads();
}

constexpr int NWAVES = 8;
constexpr int RING_BYTES = 131072, LDSCTL_OFF = RING_BYTES, MISC_OFF = LDSCTL_OFF + 320, LDS_BYTES = 147456;
constexpr int CW_BAR = 4096;
constexpr int NPHASE = 13;
#ifndef MK_N_LAUNCHES
#define MK_N_LAUNCHES 1
#endif
constexpr int N_LAUNCHES = MK_N_LAUNCHES;

#define LDS_WAIT() asm volatile("s_waitcnt lgkmcnt(0)" ::: "memory")
__device__ __forceinline__ float wave_sum(float v) {
#pragma unroll
    for (int o = 1; o < 64; o <<= 1) v += __shfl_xor(v, o);
    return v;
}
__device__ __forceinline__ void p0_transpose_item(const float* W, int K, int N, bf16_t* WT, int k0, int n0, int orow0, LAS float* scr, int lane) {
#pragma unroll 8
    for (int i = 0; i < 32; ++i) { const int kk = 2 * i + (lane >> 5); scr[kk * 33 + (lane & 31)] = W[(size_t)(k0 + kk) * N + n0 + (lane & 31)]; }
    LDS_WAIT(); asm volatile("" ::: "memory");
    const int c = lane & 7;
#pragma unroll
    for (int j = 0; j < 4; ++j) { const int n = (lane >> 3) + 8 * j; const LAS float* s = scr + (8 * c) * 33 + n;
        u32x4 o; o.x = cvtpk(s[0 * 33], s[1 * 33]); o.y = cvtpk(s[2 * 33], s[3 * 33]); o.z = cvtpk(s[4 * 33], s[5 * 33]); o.w = cvtpk(s[6 * 33], s[7 * 33]);
        *(u32x4*)(WT + (size_t)(orow0 + n) * K + k0 + 8 * c) = o; }
    LDS_WAIT(); asm volatile("" ::: "memory");
}
__device__ __forceinline__ void sincos_d(double a, double& s, double& c) {
    const double k = __builtin_rint(a * 0.63661977236758134308);
    double r = __builtin_fma(-k, 1.57079632679489655800e+00, a); r = __builtin_fma(-k, 6.12323399573676603587e-17, r);
    const double r2 = r * r;
    double sp = -7.6471637318198164759e-13; sp = sp * r2 + 1.6059043836821614599e-10; sp = sp * r2 - 2.5052108385441718775e-08; sp = sp * r2 + 2.7557319223985890653e-06;
    sp = sp * r2 - 1.9841269841269841270e-04; sp = sp * r2 + 8.3333333333333333333e-03; sp = sp * r2 - 1.6666666666666666667e-01; const double sr = r + r * r2 * sp;
    double cp = 4.7794773323873852974e-14; cp = cp * r2 - 1.1470745597729724714e-11; cp = cp * r2 + 2.0876756987868098979e-09; cp = cp * r2 - 2.7557319223985890653e-07;
    cp = cp * r2 + 2.4801587301587301587e-05; cp = cp * r2 - 1.3888888888888888889e-03; cp = cp * r2 + 4.1666666666666666667e-02; cp = cp * r2 - 0.5; const double cr = 1.0 + r2 * cp;
    const int q = ((int)k) & 3;
    s = (q == 0) ? sr : (q == 1) ? cr : (q == 2) ? -sr : -cr;
    c = (q == 0) ? cr : (q == 1) ? -sr : (q == 2) ? -cr : sr;
}

struct Args { const float* in[32]; float* out; unsigned char* ws; int ph_lo, ph_hi, li, pad; };

__global__ void __launch_bounds__(NWAVES * 64, 2) mk_fwd(Args args) {
    extern __shared__ __attribute__((aligned(16))) unsigned char lds_raw[];
    LAS unsigned char* lds = (LAS unsigned char*)lds_raw;
    volatile LAS unsigned* MISC = (volatile LAS unsigned*)(lds + MISC_OFF);
    const int tid = threadIdx.x, lane = tid & 63, wave = __builtin_amdgcn_readfirstlane(tid >> 6);
    const int G = gridDim.x, bx = blockIdx.x;
    const int gw = bx * NWAVES + wave, NGW = G * NWAVES;
    unsigned char* ws = args.ws; float* out = args.out;
    gu32* ctl = (gu32*)(ws + WS_CTL);
    for (int u = tid; u < (LDS_BYTES - LDSCTL_OFF) / 4; u += NWAVES * 64) ((LAS unsigned*)(lds + LDSCTL_OFF))[u] = 0u;
    __syncthreads();
    XcdBarrier bar; bar.bar = (unsigned*)(ctl + CW_BAR); bar.x = 0; bar.st = nullptr;
    if (N_LAUNCHES == 1) bar = xcd_barrier_post((unsigned*)(ctl + CW_BAR), MISC + 8);
#define GRID_BAR() do { if (N_LAUNCHES == 1) xcd_barrier(bar); } while (0)
    const int lo = args.ph_lo, hi_ph = args.ph_hi;
#define IN(k) (lo <= (k) && (k) < hi_ph)
#define SEAM(k) do { if (IN(k) && IN((k) + 1)) GRID_BAR(); } while (0)

    const float* x_prompt = args.in[0]; const float* x_sample = args.in[1]; const float* mem_prompt = args.in[2];
    bf16_t* Wqkv_t = (bf16_t*)(ws + WS_WQKV); bf16_t* Wo_t = (bf16_t*)(ws + WS_WO); bf16_t* Wmq_t = (bf16_t*)(ws + WS_WMQ); bf16_t* Wmkv_t = (bf16_t*)(ws + WS_WMKV);
    bf16_t* Wmo_t = (bf16_t*)(ws + WS_WMO); bf16_t* Wup_t = (bf16_t*)(ws + WS_WUP); bf16_t* Wdn_t = (bf16_t*)(ws + WS_WDN);
    bf16_t* MEMB = (bf16_t*)(ws + WS_MEMB); bf16_t* MKB = (bf16_t*)(ws + WS_MKB); bf16_t* MVB = (bf16_t*)(ws + WS_MVB);
    bf16_t* KAS = (bf16_t*)(ws + WS_KAS); bf16_t* VAS = (bf16_t*)(ws + WS_VAS); bf16_t* KBS = (bf16_t*)(ws + WS_KBS); bf16_t* VBS = (bf16_t*)(ws + WS_VBS);
    bf16_t* MKS = (bf16_t*)(ws + WS_MKS); bf16_t* MVS = (bf16_t*)(ws + WS_MVS);
    bf16_t* QKVB = (bf16_t*)(ws + WS_QKVB); bf16_t* XB = (bf16_t*)(ws + WS_XB); bf16_t* OD = (bf16_t*)(ws + WS_OD); bf16_t* MIXA = (bf16_t*)(ws + WS_MIXA);
    bf16_t* X1B = (bf16_t*)(ws + WS_X1B); bf16_t* X2B = (bf16_t*)(ws + WS_X2B); bf16_t* QM = (bf16_t*)(ws + WS_QM); bf16_t* OM = (bf16_t*)(ws + WS_OM); bf16_t* HB = (bf16_t*)(ws + WS_H);
    float* ROPE = (float*)(ws + WS_ROPE); float* BT = (float*)(ws + WS_BT); float* LAMP = (float*)(ws + WS_LAM);
    float* R = out + OFF_Y;

    if (IN(0)) {
        LAS float* scr = (LAS float*)(lds + wave * 16384);
        {
            constexpr int I_QKV = 16 * 96, I_SQ = 16 * 32, I_UP = 16 * 176, I_DN = 44 * 32;
            constexpr int NITEMS = I_QKV + 5 * I_SQ + I_UP + I_DN;
            for (int it = gw; it < NITEMS; it += NGW) {
                int r = it;
                if (r < I_QKV) { const int kb = r / 96, nb = r % 96; p0_transpose_item(args.in[10], 1024, 3072, Wqkv_t, kb * 64, nb * 32, nb * 32, scr, lane); continue; } r -= I_QKV;
                if (r < I_SQ) { const int kb = r / 32, nb = r % 32; p0_transpose_item(args.in[17], 1024, 1024, Wo_t, kb * 64, nb * 32, nb * 32, scr, lane); continue; } r -= I_SQ;
                if (r < I_SQ) { const int kb = r / 32, nb = r % 32; p0_transpose_item(args.in[20], 1024, 1024, Wmq_t, kb * 64, nb * 32, nb * 32, scr, lane); continue; } r -= I_SQ;
                if (r < I_SQ) { const int kb = r / 32, nb = r % 32; p0_transpose_item(args.in[21], 1024, 1024, Wmkv_t, kb * 64, nb * 32, nb * 32, scr, lane); continue; } r -= I_SQ;
                if (r < I_SQ) { const int kb = r / 32, nb = r % 32; p0_transpose_item(args.in[22], 1024, 1024, Wmkv_t, kb * 64, nb * 32, 1024 + nb * 32, scr, lane); continue; } r -= I_SQ;
                if (r < I_SQ) { const int kb = r / 32, nb = r % 32; p0_transpose_item(args.in[23], 1024, 1024, Wmo_t, kb * 64, nb * 32, nb * 32, scr, lane); continue; } r -= I_SQ;
                if (r < I_UP) { const int kb = r / 176, nb = r % 176, n0 = nb * 32, bj = n0 / DFF, f = n0 % DFF; p0_transpose_item(args.in[26], 1024, DFF2, Wup_t, kb * 64, n0, 256 * (f / 128) + 128 * bj + (f % 128), scr, lane); continue; } r -= I_UP;
                { const int kb = r / 32, nb = r % 32; p0_transpose_item(args.in[29], DFF, 1024, Wdn_t, kb * 64, nb * 32, nb * 32, scr, lane); }
            }
        }
        for (int m = gw; m < MROWS + 256; m += NGW) {
            const float* src = (m < SEQ) ? x_prompt + (size_t)m * DM : (m < MROWS) ? x_sample + (size_t)(m - SEQ) * DM : mem_prompt + (size_t)(m - MROWS) * DM;
            bf16_t* dst = (m < MROWS) ? XB + (size_t)m * DM : MEMB + (size_t)(m - MROWS) * DM;
#pragma unroll
            for (int j = 0; j < 4; ++j) { const f32x4 v = *((const f32x4*)src + lane + 64 * j); u32x2 w; w.x = cvtpk(v[0], v[1]); w.y = cvtpk(v[2], v[3]); *((u32x2*)dst + lane + 64 * j) = w; }
        }
        {
            const int gt = bx * (NWAVES * 64) + tid, NT = G * NWAVES * 64;
            for (int i = gt; i < 8 * 512 * 128; i += NT) { const int b = i / (512 * 128), rem = i % (512 * 128);
                const f32x4 a = *((const f32x4*)args.in[3] + i), v = *((const f32x4*)args.in[4] + i); u32x2 w;
                w.x = cvtpk(a[0], a[1]); w.y = cvtpk(a[2], a[3]); *(u32x2*)(KAS + (size_t)b * 544 * 512 + (size_t)rem * 4) = w;
                w.x = cvtpk(v[0], v[1]); w.y = cvtpk(v[2], v[3]); *(u32x2*)(VAS + (size_t)b * 544 * 512 + (size_t)rem * 4) = w; }
            for (int i = gt; i < 8 * 1024 * 128; i += NT) { const int b = i / (1024 * 128), rem = i % (1024 * 128);
                const f32x4 a = *((const f32x4*)args.in[5] + i), v = *((const f32x4*)args.in[6] + i); u32x2 w;
                w.x = cvtpk(a[0], a[1]); w.y = cvtpk(a[2], a[3]); *(u32x2*)(KBS + (size_t)b * 1056 * 512 + (size_t)rem * 4) = w;
                w.x = cvtpk(v[0], v[1]); w.y = cvtpk(v[2], v[3]); *(u32x2*)(VBS + (size_t)b * 1056 * 512 + (size_t)rem * 4) = w; }
            for (int i = gt; i < 8 * 256 * 256; i += NT) {
                const f32x4 a = *((const f32x4*)args.in[7] + i), v = *((const f32x4*)args.in[8] + i); u32x2 w;
                w.x = cvtpk(a[0], a[1]); w.y = cvtpk(a[2], a[3]); *(u32x2*)(MKS + (size_t)i * 4) = w;
                w.x = cvtpk(v[0], v[1]); w.y = cvtpk(v[2], v[3]); *(u32x2*)(MVS + (size_t)i * 4) = w; }
            for (int i = gt; i < SEQ * 8; i += NT) { const int pos = i >> 3, j = i & 7;
                const double inv = (j == 0) ? 1.0 : (j == 1) ? 0.19392274474868576 : (j == 2) ? 0.03760603093086393 : (j == 3) ? 0.007292664737217109 : (j == 4) ? 0.001414213562373095 :
                                   (j == 5) ? 0.0002742481756762073 : (j == 6) ? 5.318295896944988e-05 : 1.031338537721246e-05;
                double s, c; sincos_d((double)pos * inv, s, c); ROPE[(size_t)pos * 16 + j] = (float)c; ROPE[(size_t)pos * 16 + 8 + j] = (float)s; }
            for (int i = gt; i < 8 * 640; i += NT) { const int h = i / 640, rel = (i % 640) - 63; const int cl = rel < -128 ? -128 : (rel > 128 ? 128 : rel);
                BT[i] = args.in[11][h * 257 + cl + 128] * LOG2E; }
            if (gt == 0) { float s1 = 0.f, s2 = 0.f; for (int d = 0; d < 64; ++d) { s1 += args.in[12][d] * args.in[13][d]; s2 += args.in[14][d] * args.in[15][d]; }
                LAMP[0] = expf(s1) - expf(s2) + 0.2f; }
        }
    }
    SEAM(0);
    if (IN(1)) {
        { pg8::Gemm g{XB, Wqkv_t, DM, DM, DM}; pg8::StaticOrder S; S.init(65, 12, G, bx);
          pg8::EpiQKV E{QKVB, out, ROPE, KAS, VAS, KBS, VBS};
          pg8::gemm_phase<pg8::EpiQKV, 0, true, true>(lds, g, S, E); }
        { pg8::Gemm g{MEMB, Wmkv_t, DM, DM, DM}; pg8::StaticOrder S; S.init(1, 8, G, (bx + G - 12) % G);
          pg8::EpiMemKV E{out, MKB, MVB};
          pg8::gemm_phase<pg8::EpiMemKV, 0, true, true>(lds, g, S, E); }
    }
    SEAM(1);
    if (IN(2)) {
        LAS unsigned char* wl = lds + wave * 8192;
        for (int i = 0; i * NGW < 8192; ++i) {
            const int rank = i * NGW + ((i & 1) ? (NGW - 1 - gw) : gw);
            if (rank >= 8192) continue;
            const int qblk = 511 - (rank >> 4), hmv = rank & 15, hm = hmv >> 1, vh = hmv & 1, c = qblk >> 1;
            gsa_wave<64, false>(QKVB + (size_t)(qblk * 32) * NQKV + 1536 + hm * 64, NQKV, QKVB + 2048 + hm * 64, NQKV, QKVB + 2560 + (hm >> 1) * 128 + vh * 64, NQKV, 64 * (c + 1),
                                nullptr, 0, OD + (size_t)(qblk * 32) * DM + hm * 128 + vh * 64, DM, wl, lane);
        }
        for (int u = gw; u < 4096; u += NGW) {
            const int qblk = u >> 3, h = u & 7, c = qblk >> 1, klo = (64 * c - 512) < 0 ? 0 : (64 * c - 512), nk = 64 * c + 64 - klo;
            gsa_wave<64, true>(QKVB + (size_t)(qblk * 32) * NQKV + h * 64, NQKV, QKVB + (size_t)klo * NQKV + 512 + h * 64, NQKV, QKVB + (size_t)klo * NQKV + 1024 + h * 64, NQKV, nk,
                               BT + h * 640, qblk * 32 - klo + 63, MIXA + (size_t)(qblk * 32) * DM + h * 64, DM, wl, lane);
        }
        for (int u = gw; u < 192; u += NGW) {
            if (u < 64) { const int b = u >> 3, h = u & 7;
                gsa_wave<64, true>(QKVB + (size_t)(SEQ + b * 32) * NQKV + h * 64, NQKV, KAS + (size_t)b * 544 * 512 + h * 64, 512, VAS + (size_t)b * 544 * 512 + h * 64, 512, 544,
                                   BT + h * 640, 512 + 63, MIXA + (size_t)(SEQ + b * 32) * DM + h * 64, DM, wl, lane);
            } else { const int v = u - 64, b = v >> 4, hmv = v & 15, hm = hmv >> 1, vh = hmv & 1;
                gsa_wave<64, false>(QKVB + (size_t)(SEQ + b * 32) * NQKV + 1536 + hm * 64, NQKV, KBS + (size_t)b * 1056 * 512 + hm * 64, 512, VBS + (size_t)b * 1056 * 512 + (hm >> 1) * 128 + vh * 64, 512, 1056,
                                    nullptr, 0, OD + (size_t)(SEQ + b * 32) * DM + hm * 128 + vh * 64, DM, wl, lane);
            }
        }
    }
    SEAM(2);
    if (IN(3)) {
        const float lam = LAMP[0];
        const int h = lane >> 4, d0 = (lane & 15) * 8;
        f32x4 g0 = *(const f32x4*)(args.in[16] + d0), g1 = *(const f32x4*)(args.in[16] + d0 + 4);
        for (int m = gw; m < MROWS; m += NGW) {
            const u32x4 a = *(const u32x4*)(OD + (size_t)m * DM + h * 256 + d0), b = *(const u32x4*)(OD + (size_t)m * DM + h * 256 + 128 + d0);
            float o[8]; float ss = 0.f;
#pragma unroll
            for (int j = 0; j < 4; ++j) { const unsigned ua = a[j], ub = b[j];
                o[2 * j] = __uint_as_float(ua << 16) - lam * __uint_as_float(ub << 16); o[2 * j + 1] = __uint_as_float(ua & 0xffff0000u) - lam * __uint_as_float(ub & 0xffff0000u);
                ss += o[2 * j] * o[2 * j] + o[2 * j + 1] * o[2 * j + 1]; }
            ss += __shfl_xor(ss, 1); ss += __shfl_xor(ss, 2); ss += __shfl_xor(ss, 4); ss += __shfl_xor(ss, 8);
            const float rn = 0.8f / sqrtf(ss * (1.f / 128.f) + LN_EPS);
            u32x4 w; w.x = cvtpk(o[0] * rn * g0[0], o[1] * rn * g0[1]); w.y = cvtpk(o[2] * rn * g0[2], o[3] * rn * g0[3]); w.z = cvtpk(o[4] * rn * g1[0], o[5] * rn * g1[1]); w.w = cvtpk(o[6] * rn * g1[2], o[7] * rn * g1[3]);
            *(u32x4*)(MIXA + (size_t)m * DM + 512 + h * 128 + d0) = w;
        }
    }
    SEAM(3);
    if (IN(4)) {
        pg8::Gemm g{MIXA, Wo_t, DM, DM, DM}; pg8::StaticOrder S; S.init(65, 4, G, bx);
        pg8::EpiResid E{x_prompt, x_sample, R};
        pg8::gemm_phase<pg8::EpiResid, 0, true, true>(lds, g, S, E);
    }
    SEAM(4);
#define LN_PASS(gp, bp, XO) do { \
        for (int m = gw; m < MROWS; m += NGW) { \
            f32x4* xr = (f32x4*)(R + (size_t)m * DM) + lane; f32x4 v[4]; float s = 0.f; \
            _Pragma("unroll") for (int j = 0; j < 4; ++j) { v[j] = xr[64 * j]; s += (v[j][0] + v[j][1]) + (v[j][2] + v[j][3]); } \
            const float mean = wave_sum(s) * (1.f / DM); float s2 = 0.f; \
            _Pragma("unroll") for (int j = 0; j < 4; ++j) { v[j] = v[j] - mean; s2 += (v[j][0] * v[j][0] + v[j][1] * v[j][1]) + (v[j][2] * v[j][2] + v[j][3] * v[j][3]); } \
            const float rstd = 1.f / sqrtf(wave_sum(s2) * (1.f / DM) + LN_EPS); \
            _Pragma("unroll") for (int j = 0; j < 4; ++j) { const f32x4 gg = *((const f32x4*)(gp) + lane + 64 * j), bb = *((const f32x4*)(bp) + lane + 64 * j); \
                const f32x4 y = v[j] * rstd * gg + bb; xr[64 * j] = y; \
                if (XO) { u32x2 w; w.x = cvtpk(y[0], y[1]); w.y = cvtpk(y[2], y[3]); *((u32x2*)((bf16_t*)(XO) + (size_t)m * DM) + lane + 64 * j) = w; } } \
        } } while (0)
    if (IN(5)) { LN_PASS(args.in[18], args.in[19], X1B); }
    SEAM(5);
    if (IN(6)) {
        pg8::Gemm g{X1B, Wmq_t, DM, DM, DM}; pg8::StaticOrder S; S.init(65, 4, G, bx);
        pg8::EpiBf16S E{QM, DM, C2M};
        pg8::gemm_phase<pg8::EpiBf16S, 0, true, true>(lds, g, S, E);
    }
    SEAM(6);
    if (IN(7)) {
        LAS unsigned char* wl = lds + wave * 8192;
        for (int u = gw; u < 520 * 16; u += NGW) {
            const int qblk = u >> 4, h = (u >> 2) & 3, vc = u & 3;
            const bf16_t* kk = (qblk < 512) ? MKB : MKS + (size_t)(qblk - 512) * 256 * 1024; const bf16_t* vv = (qblk < 512) ? MVB : MVS + (size_t)(qblk - 512) * 256 * 1024;
            gsa_wave<256, false>(QM + (size_t)(qblk * 32) * DM + h * 256, DM, kk + h * 256, DM, vv + h * 256 + vc * 64, DM, 256, nullptr, 0, OM + (size_t)(qblk * 32) * DM + h * 256 + vc * 64, DM, wl, lane);
        }
    }
    SEAM(7);
    if (IN(8)) {
        pg8::Gemm g{OM, Wmo_t, DM, DM, DM}; pg8::StaticOrder S; S.init(65, 4, G, bx);
        pg8::EpiResid E{R, R + (size_t)SEQ * DM, R};
        pg8::gemm_phase<pg8::EpiResid, 0, true, true>(lds, g, S, E);
    }
    SEAM(8);
    if (IN(9)) {
        if (bx == 0) { for (int i = tid; i < 1024; i += NWAVES * 64) ((unsigned*)(ws + WS_X2B - 4096))[i] = 0u; }
        LN_PASS(args.in[24], args.in[25], X2B);
    }
    SEAM(9);
    if (IN(10)) {
        { pg8::Gemm g{X2B, Wup_t, DM, DM, DM}; pg8::StaticOrder S; S.init(67, 22, G, bx);
          pg8::EpiUpConv<false> E{HB, args.in[27], args.in[28], args.in[9], out + OFF_CVP, out + OFF_CVS};
          pg8::gemm_phase<pg8::EpiUpConv<false>, 1, true, true>(lds, g, S, E); }
        { pg8::Gemm g{X2B + (size_t)SEQ * DM, Wup_t, DM, DM, DM}; pg8::StaticOrder S; S.init(1, 22, G, (bx + G - 194) % G);
          pg8::EpiUpConv<true> E{HB, args.in[27], args.in[28], args.in[9], out + OFF_CVP, out + OFF_CVS};
          pg8::gemm_phase<pg8::EpiUpConv<true>, 0, true, true>(lds, g, S, E); }
    }
    SEAM(10);
    if (IN(11)) {
        pg8::Gemm g{HB, Wdn_t, DFF, DFF, DFF}; pg8::StaticOrder S; S.init(65, 4, G, bx);
        pg8::EpiResid E{R, R + (size_t)SEQ * DM, R};
        pg8::gemm_phase<pg8::EpiResid, 0, true, true>(lds, g, S, E);
    }
    SEAM(11);
    if (IN(12)) { LN_PASS(args.in[30], args.in[31], (bf16_t*)nullptr); }
#undef IN
#undef SEAM
}

extern "C" void kernel_launch(void* const* d_in, const int* in_sizes, int n_in, void* d_out, int out_size, void* d_ws, size_t ws_size, hipStream_t stream) {
    static int grid = 0;
    if (grid == 0) {
        int dev = 0, cus = 0;
        if (hipGetDevice(&dev) != hipSuccess || hipDeviceGetAttribute(&cus, hipDeviceAttributeMultiprocessorCount, dev) != hipSuccess) { fprintf(stderr, "kernel_launch: device query failed\n"); grid = -1; return; }
        if (hipFuncSetAttribute((const void*)mk_fwd, hipFuncAttributeMaxDynamicSharedMemorySize, LDS_BYTES) != hipSuccess) { fprintf(stderr, "kernel_launch: hipFuncSetAttribute failed\n"); grid = -1; return; }
        int per_cu = 0;
        if (hipOccupancyMaxActiveBlocksPerMultiprocessor(&per_cu, (const void*)mk_fwd, NWAVES * 64, LDS_BYTES) != hipSuccess || per_cu < 1) fprintf(stderr, "kernel_launch: occupancy query reports %d\n", per_cu);
        (void)hipGetLastError();
        grid = cus;
        fprintf(stderr, "kernel_launch: grid %d, ws %zu, n_in %d, out %d\n", grid, ws_size, n_in, out_size);
    }
    if (grid < 0) return;
    (void)hipMemsetAsync((char*)d_ws + WS_CTL, 0, CTL_ZERO_BYTES, stream);
    Args a{};
    for (int i = 0; i < 32; ++i) a.in[i] = (const float*)d_in[i];
    a.out = (float*)d_out; a.ws = (unsigned char*)d_ws;
    if (N_LAUNCHES == 1) { a.ph_lo = 0; a.ph_hi = NPHASE; a.li = 0; hipLaunchKernelGGL(mk_fwd, dim3(grid), dim3(NWAVES * 64), LDS_BYTES, stream, a); }
    else for (int li = 0; li < NPHASE; ++li) { a.ph_lo = li; a.ph_hi = li + 1; a.li = li; hipLaunchKernelGGL(mk_fwd, dim3(grid), dim3(NWAVES * 64), LDS_BYTES, stream, a); }
}
```

```cpp
#include <hip/hip_runtime.h>
#include <cstdio>
#include <cstdint>

#define LAS __attribute__((address_space(3)))
#define GAS __attribute__((address_space(1)))
typedef unsigned short bf16_t;
typedef short bf16x8 __attribute__((ext_vector_type(8)));
typedef short s16x4 __attribute__((ext_vector_type(4)));
typedef float f32x2 __attribute__((ext_vector_type(2)));
typedef float f32x4 __attribute__((ext_vector_type(4)));
typedef float f32x16 __attribute__((ext_vector_type(16)));
typedef unsigned u32x2 __attribute__((ext_vector_type(2)));
typedef unsigned u32x4 __attribute__((ext_vector_type(4)));
typedef __bf16 bf16x2_t __attribute__((ext_vector_type(2)));

constexpr int DM = 1024, SEQ = 16384, NSAMP = 256, MROWS = SEQ + NSAMP;
constexpr int NQKV = 3072, DFF = 2816, DFF2 = 5632;
constexpr float LN_EPS = 1e-5f;
constexpr float ALPHA = 1.189207115002721f;
constexpr float LOG2E = 1.4426950408889634f;
constexpr float C2 = 0.125f * LOG2E;
constexpr float C2M = 0.0625f * LOG2E;
constexpr size_t OFF_Y = 0, OFF_AKP = 17039360, OFF_AVP = 17301504, OFF_BKP = 17563648, OFF_BVP = 25952256, OFF_MKP = 34340864, OFF_MVP = 34603008,
                 OFF_CVP = 34865152, OFF_AKS = 34876416, OFF_AVS = 35007488, OFF_BKS = 35138560, OFF_BVS = 35269632, OFF_CVS = 35400704;
constexpr size_t MiB = 1u << 20;
constexpr size_t WS_CTL = 0, CTL_ZERO_BYTES = 1 * MiB;
constexpr size_t WS_ROPE = 1 * MiB, WS_BT = 2 * MiB, WS_LAM = 2 * MiB + 32768;
constexpr size_t WS_WQKV = 3 * MiB, WS_WO = 9 * MiB, WS_WMQ = 11 * MiB, WS_WMKV = 13 * MiB, WS_WMO = 17 * MiB, WS_WUP = 19 * MiB, WS_WDN = 30 * MiB;
constexpr size_t WS_MEMB = 36 * MiB, WS_MKB = 36 * MiB + 512 * 1024, WS_MVB = 37 * MiB;
constexpr size_t WS_KAS = 38 * MiB, WS_VAS = 42 * MiB + 512 * 1024, WS_KBS = 47 * MiB, WS_VBS = 55 * MiB + 512 * 1024, WS_MKS = 64 * MiB, WS_MVS = 68 * MiB;
constexpr size_t WS_QKVB = 72 * MiB, WS_XB = 170 * MiB, WS_OD = 170 * MiB, WS_MIXA = 203 * MiB, WS_X1B = 203 * MiB, WS_X2B = 203 * MiB + 4096;
constexpr size_t WS_QM = 72 * MiB, WS_OM = 105 * MiB, WS_H = 72 * MiB;

__device__ __forceinline__ unsigned cvtpk(float lo, float hi) { f32x2 v = {lo, hi}; bf16x2_t b = __builtin_convertvector(v, bf16x2_t); return __builtin_bit_cast(unsigned, b); }
__device__ __forceinline__ bf16_t f2bf(float f) { return (bf16_t)(cvtpk(f, 0.f) & 0xffffu); }

namespace pg8 {
constexpr int BM = 256, BK = 64, HALF = 128, HTB = HALF * BK * 2, STAGE_BYTES = 8 * HTB, NXCD = 8, WGM = 8;
__host__ __device__ __forceinline__ int lds_byte(int r, int c) { const int st = (r >> 4) * 2 + (c >> 5), rr = r & 15, cc = c & 31, ob = rr * 64 + cc * 2; return st * 1024 + (ob ^ (((ob >> 9) & 1) << 5)); }
__host__ __device__ __forceinline__ void stage_rc(int b, int& R, int& C) { const int st = b / 1024, sb = b % 1024, swz = sb ^ (((sb >> 9) & 1) << 5); R = (st >> 1) * 16 + swz / 64; C = (st & 1) * 32 + (swz % 64) / 2; }
__host__ __device__ __forceinline__ int perm32(int rho) { const int n = rho >> 4, i = rho & 15; return 8 * (i >> 2) + 4 * n + (i & 3); }
struct Unit { int pm, pn; };
struct Gemm { const bf16_t* A; const bf16_t* Bt; int lda, ldb, K; };
struct StaticOrder {
    int nM, nN, nwg, G, c;
    __host__ __device__ void init(int nM_, int nN_, int G_, int c_) { nM = nM_; nN = nN_; nwg = nM * nN; G = G_; c = c_; }
    __host__ __device__ bool next(int i, Unit& u) const {
        const long L = (long)i * G + c; if (L >= nwg) return false;
        int wgid = (int)L; { const int q = nwg / NXCD, r = nwg % NXCD, xcd = wgid % NXCD, off = wgid / NXCD; wgid = (xcd < r ? xcd * (q + 1) : r * (q + 1) + (xcd - r) * q) + off; }
        const int nig = WGM * nN, gid = wgid / nig, fm = gid * WGM, gsz = (nM - fm) < WGM ? (nM - fm) : WGM;
        u.pm = fm + ((wgid % nig) % gsz); u.pn = (wgid % nig) / gsz; return true;
    }
};
template <class Epi, int AMODE, bool ALIGN_EPI, bool SP2>
__device__ __forceinline__ void gemm_phase(LAS unsigned char* lds, const Gemm g, const StaticOrder& S, const Epi& E) {
    const int tid = threadIdx.x, wid = __builtin_amdgcn_readfirstlane(tid >> 6), lane = tid & 63, wr = wid >> 2, wc = wid & 3, fr = lane & 15, fq = lane >> 4;
    const int K = g.K, nt = K / BK;
    unsigned voffA[2], voffB[2];
#pragma unroll
    for (int i = 0; i < 2; ++i) { int R, C; stage_rc(tid * 16 + i * 8192, R, C); const int Rb = Epi::PERM ? ((R & ~31) + perm32(R & 31)) : R;
        const int Ra = (AMODE == 1) ? (62 * (R >> 6) + (R & 63)) : R;
        voffA[i] = (unsigned)(Ra * g.lda + C) * 2u; voffB[i] = (unsigned)(Rb * g.ldb + C) * 2u; }
    const size_t kstep = (size_t)(BK * 2);
    const size_t hstepA = (size_t)((AMODE == 1) ? 124 : 128) * g.lda * 2, hstepB = (size_t)HALF * g.ldb * 2;
    const unsigned ldsw = (unsigned)wid * 1024u;
    const int aoff = lds_byte(wr * 64 + fr, fq * 8), boff = lds_byte(wc * 32 + fr, fq * 8);
#define PG8_TILEA(pm) ((const char*)g.A + (ptrdiff_t)((AMODE == 1) ? (248 * (pm) - 2) : (256 * (pm))) * g.lda * 2)
#define PG8_TILEB(pn) ((const char*)g.Bt + (size_t)(256 * (pn)) * g.ldb * 2)
#define PG8_SA(b, h) (((b) * 2 + (h)) * HTB)
#define PG8_SB(b, h) ((4 + (b) * 2 + (h)) * HTB)
#define PG8_STAGE(bufoff, gbase, voff) do { _Pragma("unroll") for (int _i = 0; _i < 2; ++_i) \
        __builtin_amdgcn_global_load_lds((const unsigned*)((const char*)(gbase) + (voff)[_i]), (LAS unsigned*)(lds + (bufoff) + ldsw + _i * 8192), 16, 0, 0); } while (0)
#define PG8_LDA(dst, b, h) do { _Pragma("unroll") for (int m = 0; m < 4; ++m) _Pragma("unroll") for (int k = 0; k < 2; ++k) dst[m][k] = *(const LAS bf16x8*)(lds + PG8_SA(b, h) + aoff + m * 2048 + k * 1024); } while (0)
#define PG8_LDB(dst, b, h) do { _Pragma("unroll") for (int n = 0; n < 2; ++n) _Pragma("unroll") for (int k = 0; k < 2; ++k) dst[n][k] = *(const LAS bf16x8*)(lds + PG8_SB(b, h) + boff + n * 2048 + k * 1024); } while (0)
#define PG8_MMA(ai, bj, At, Bt) do { __builtin_amdgcn_s_setprio(1); _Pragma("unroll") for (int m = 0; m < 4; ++m) _Pragma("unroll") for (int n = 0; n < 2; ++n) _Pragma("unroll") for (int k = 0; k < 2; ++k) \
        acc[ai][bj][m][n] = __builtin_amdgcn_mfma_f32_16x16x32_bf16(Bt[n][k], At[m][k], acc[ai][bj][m][n], 0, 0, 0); __builtin_amdgcn_s_setprio(0); } while (0)
#define PG8_WAIT_V(n) asm volatile("s_waitcnt vmcnt(" #n ")" ::: "memory")
#define PG8_WAIT_L(n) asm volatile("s_waitcnt lgkmcnt(" #n ")" ::: "memory")
#define PG8_BAR __builtin_amdgcn_s_barrier()
#define PG8_SCHED __builtin_amdgcn_sched_barrier(0)
    Unit cur, nxt; int ui = 0;
    if (!S.next(0, cur)) return;
    f32x4 acc[2][2][4][2];
#pragma unroll
    for (int a = 0; a < 2; ++a)
#pragma unroll
        for (int b = 0; b < 2; ++b)
#pragma unroll
            for (int m = 0; m < 4; ++m)
#pragma unroll
                for (int n = 0; n < 2; ++n) acc[a][b][m][n] = (f32x4){0.f, 0.f, 0.f, 0.f};
    bf16x8 At[4][2], B0[2][2], B1[2][2];
    const char* cA = PG8_TILEA(cur.pm); const char* cB = PG8_TILEB(cur.pn);
    if constexpr (SP2) {
        PG8_STAGE(PG8_SB(0, 0), cB, voffB); PG8_STAGE(PG8_SB(0, 1), cB + hstepB, voffB); PG8_STAGE(PG8_SA(0, 0), cA, voffA); PG8_STAGE(PG8_SA(0, 1), cA + hstepA, voffA);
        if (wr == 1) PG8_BAR;
        PG8_WAIT_V(2); PG8_BAR;
        PG8_STAGE(PG8_SB(1, 0), cB + kstep, voffB); PG8_STAGE(PG8_SA(1, 0), cA + kstep, voffA); PG8_STAGE(PG8_SB(1, 1), cB + hstepB + kstep, voffB);
        PG8_WAIT_V(6); PG8_BAR;
    } else {
        PG8_STAGE(PG8_SB(0, 0), cB, voffB); PG8_STAGE(PG8_SA(0, 0), cA, voffA); PG8_STAGE(PG8_SB(0, 1), cB + hstepB, voffB); PG8_STAGE(PG8_SA(0, 1), cA + hstepA, voffA);
        if (wr == 1) PG8_BAR;
        PG8_WAIT_V(4); PG8_BAR;
        PG8_STAGE(PG8_SB(1, 0), cB + kstep, voffB); PG8_STAGE(PG8_SA(1, 0), cA + kstep, voffA); PG8_STAGE(PG8_SB(1, 1), cB + hstepB + kstep, voffB);
        PG8_WAIT_V(6); PG8_BAR;
    }
    for (;;) {
        const bool has_next = S.next(ui + 1, nxt);
        const char* nA = has_next ? PG8_TILEA(nxt.pm) : cA; const char* nB = has_next ? PG8_TILEB(nxt.pn) : cB;
        for (int t = 0; t < nt; t += 2) {
            const bool last = (t == nt - 2);
            const char* a1 = cA + (size_t)(t + 1) * kstep;
            const char* a2 = last ? nA : cA + (size_t)(t + 2) * kstep; const char* b2 = last ? nB : cB + (size_t)(t + 2) * kstep;
            const char* a3 = a2 + kstep; const char* b3 = b2 + kstep;
            if constexpr (SP2) {
            PG8_LDB(B0, 0, 0); PG8_LDB(B1, 0, 1); PG8_SCHED; PG8_LDA(At, 0, 0); PG8_STAGE(PG8_SA(1, 1), a1 + hstepA, voffA);
            PG8_WAIT_V(8); PG8_WAIT_L(0); PG8_BAR; PG8_MMA(0, 0, At, B0); PG8_MMA(0, 1, At, B1); PG8_BAR; PG8_SCHED;
            PG8_LDA(At, 0, 1); PG8_STAGE(PG8_SB(0, 0), b2, voffB); PG8_STAGE(PG8_SB(0, 1), b2 + hstepB, voffB); PG8_STAGE(PG8_SA(0, 0), a2, voffA);
            PG8_WAIT_V(8); PG8_WAIT_L(0); PG8_BAR; PG8_MMA(1, 0, At, B0); PG8_MMA(1, 1, At, B1); PG8_BAR; PG8_SCHED;
            PG8_LDB(B0, 1, 0); PG8_LDB(B1, 1, 1); PG8_SCHED; PG8_LDA(At, 1, 0); PG8_STAGE(PG8_SA(0, 1), a2 + hstepA, voffA);
            PG8_WAIT_V(8); PG8_WAIT_L(0); PG8_BAR; PG8_MMA(0, 0, At, B0); PG8_MMA(0, 1, At, B1); PG8_BAR; PG8_SCHED;
            PG8_LDA(At, 1, 1); PG8_STAGE(PG8_SB(1, 0), b3, voffB); PG8_STAGE(PG8_SB(1, 1), b3 + hstepB, voffB); PG8_STAGE(PG8_SA(1, 0), a3, voffA);
            PG8_WAIT_V(8); PG8_WAIT_L(0); PG8_BAR; PG8_MMA(1, 0, At, B0); PG8_MMA(1, 1, At, B1); PG8_BAR; PG8_SCHED;
            } else {
            PG8_LDB(B0, 0, 0); PG8_SCHED; PG8_LDA(At, 0, 0); PG8_STAGE(PG8_SA(1, 1), a1 + hstepA, voffA);
            PG8_WAIT_L(8); PG8_BAR; PG8_WAIT_L(0); PG8_MMA(0, 0, At, B0); PG8_BAR; PG8_SCHED;
            PG8_LDB(B1, 0, 1); PG8_STAGE(PG8_SB(0, 0), b2, voffB);
            PG8_BAR; PG8_WAIT_L(0); PG8_MMA(0, 1, At, B1); PG8_BAR;
            PG8_LDA(At, 0, 1); PG8_STAGE(PG8_SA(0, 0), a2, voffA);
            PG8_BAR; PG8_WAIT_L(0); PG8_MMA(1, 0, At, B0); PG8_BAR; PG8_SCHED;
            PG8_STAGE(PG8_SB(0, 1), b2 + hstepB, voffB);
            PG8_WAIT_V(6); PG8_BAR; PG8_MMA(1, 1, At, B1); PG8_BAR;
            PG8_LDB(B0, 1, 0); PG8_SCHED; PG8_LDA(At, 1, 0); PG8_STAGE(PG8_SA(0, 1), a2 + hstepA, voffA);
            PG8_WAIT_L(8); PG8_BAR; PG8_WAIT_L(0); PG8_MMA(0, 0, At, B0); PG8_BAR; PG8_SCHED;
            PG8_LDB(B1, 1, 1); PG8_STAGE(PG8_SB(1, 0), b3, voffB);
            PG8_BAR; PG8_WAIT_L(0); PG8_MMA(0, 1, At, B1); PG8_BAR;
            PG8_LDA(At, 1, 1); PG8_STAGE(PG8_SA(1, 0), a3, voffA);
            PG8_BAR; PG8_WAIT_L(0); PG8_MMA(1, 0, At, B0); PG8_BAR; PG8_SCHED;
            PG8_STAGE(PG8_SB(1, 1), b3 + hstepB, voffB);
            PG8_WAIT_V(6); PG8_BAR; PG8_MMA(1, 1, At, B1); PG8_BAR;
            }
        }
        if constexpr (ALIGN_EPI) { if (wr == 0) PG8_BAR; }
        E(acc, cur, wr, wc, fr, fq);
        if (!has_next) break;
#pragma unroll
        for (int a = 0; a < 2; ++a)
#pragma unroll
            for (int b = 0; b < 2; ++b)
#pragma unroll
                for (int m = 0; m < 4; ++m)
#pragma unroll
                    for (int n = 0; n < 2; ++n) acc[a][b][m][n] = (f32x4){0.f, 0.f, 0.f, 0.f};
        cur = nxt; cA = nA; cB = nB; ++ui;
        if constexpr (ALIGN_EPI) { if (wr == 1) PG8_BAR; }
    }
    PG8_WAIT_V(0);
    if constexpr (!ALIGN_EPI) { if (wr == 0) PG8_BAR; }
    PG8_BAR;
#undef PG8_TILEA
#undef PG8_TILEB
#undef PG8_SA
#undef PG8_SB
#undef PG8_STAGE
#undef PG8_LDA
#undef PG8_LDB
#undef PG8_MMA
#undef PG8_WAIT_V
#undef PG8_WAIT_L
#undef PG8_BAR
#undef PG8_SCHED
}

struct EpiQKV {
    static constexpr bool PERM = true;
    bf16_t* qkvb; float* out; const float* rope; bf16_t *kas, *vas, *kbs, *vbs;
    __device__ __forceinline__ void operator()(const f32x4 (&acc)[2][2][4][2], const Unit& u, int wr, int wc, int fr, int fq) const {
        const int pn = u.pn, pm = u.pm, region = pn >> 1;
        const bool isq = (region == 0) || (region == 3);
        const float sc = isq ? C2 : 1.f;
        const bool rope_on = (pn >= 6 && pn < 10) && ((wc & 1) == 0);
#pragma unroll
        for (int ai = 0; ai < 2; ++ai)
#pragma unroll
            for (int m = 0; m < 4; ++m) {
                const int lr = ai * 128 + wr * 64 + m * 16 + fr, grow = pm * 256 + lr;
                f32x4 cs0 = {1.f, 1.f, 1.f, 1.f}, cs1 = cs0, sn0 = {0.f, 0.f, 0.f, 0.f}, sn1 = sn0;
                if (rope_on) { const int pos = (grow < SEQ) ? grow : 1024 + ((grow - SEQ) & 31); const f32x4* rp = (const f32x4*)(rope + (size_t)pos * 16);
                    cs0 = rp[0]; cs1 = rp[1]; sn0 = rp[2]; sn1 = rp[3]; }
#pragma unroll
                for (int bj = 0; bj < 2; ++bj) {
                    f32x4 v0 = acc[ai][bj][m][0], v1 = acc[ai][bj][m][1];
                    const int c8 = pn * 256 + bj * 128 + wc * 32 + fq * 8, cr = c8 - region * 512;
                    if (rope_on) {
                        f32x4 p0, p1;
#pragma unroll
                        for (int j = 0; j < 4; ++j) { p0[j] = __shfl_xor(v0[j], 16); p1[j] = __shfl_xor(v1[j], 16); }
                        if (fq == 0) { v0 = v0 * cs0 - p0 * sn0; v1 = v1 * cs1 - p1 * sn1; }
                        else if (fq == 1) { v0 = v0 * cs0 + p0 * sn0; v1 = v1 * cs1 + p1 * sn1; }
                    }
                    float* fo = nullptr;
                    if (region == 1 || region == 2) {
                        if (pm == 64) fo = out + (region == 1 ? OFF_AKS : OFF_AVS) + (size_t)(grow - SEQ) * 512 + cr;
                        else if (grow >= SEQ - 512) fo = out + (region == 1 ? OFF_AKP : OFF_AVP) + (size_t)(grow - (SEQ - 512)) * 512 + cr;
                    } else if (region == 4 || region == 5) {
                        if (pm == 64) fo = out + (region == 4 ? OFF_BKS : OFF_BVS) + (size_t)(grow - SEQ) * 512 + cr;
                        else fo = out + (region == 4 ? OFF_BKP : OFF_BVP) + (size_t)grow * 512 + cr;
                    }
                    if (fo) { *(f32x4*)fo = v0; *(f32x4*)(fo + 4) = v1; }
                    u32x4 w; w.x = cvtpk(v0[0] * sc, v0[1] * sc); w.y = cvtpk(v0[2] * sc, v0[3] * sc); w.z = cvtpk(v1[0] * sc, v1[1] * sc); w.w = cvtpk(v1[2] * sc, v1[3] * sc);
                    *(u32x4*)(qkvb + (size_t)grow * NQKV + c8) = w;
                    if (pm == 64) { const int b = (grow - SEQ) >> 5, t = (grow - SEQ) & 31;
                        if (region == 1) *(u32x4*)(kas + ((size_t)(b * 544 + 512 + t)) * 512 + cr) = w;
                        else if (region == 2) *(u32x4*)(vas + ((size_t)(b * 544 + 512 + t)) * 512 + cr) = w;
                        else if (region == 4) *(u32x4*)(kbs + ((size_t)(b * 1056 + 1024 + t)) * 512 + cr) = w;
                        else if (region == 5) *(u32x4*)(vbs + ((size_t)(b * 1056 + 1024 + t)) * 512 + cr) = w; }
                }
            }
    }
};
struct EpiMemKV {
    static constexpr bool PERM = true;
    float* out; bf16_t *mkb, *mvb;
    __device__ __forceinline__ void operator()(const f32x4 (&acc)[2][2][4][2], const Unit& u, int wr, int wc, int fr, int fq) const {
        const bool isv = u.pn >= 4;
        float* fb = out + (isv ? OFF_MVP : OFF_MKP); bf16_t* bb = isv ? mvb : mkb;
#pragma unroll
        for (int ai = 0; ai < 2; ++ai)
#pragma unroll
            for (int m = 0; m < 4; ++m) { const int lr = ai * 128 + wr * 64 + m * 16 + fr;
#pragma unroll
                for (int bj = 0; bj < 2; ++bj) { const f32x4 v0 = acc[ai][bj][m][0], v1 = acc[ai][bj][m][1];
                    const int c8 = (u.pn & 3) * 256 + bj * 128 + wc * 32 + fq * 8;
                    *(f32x4*)(fb + (size_t)lr * 1024 + c8) = v0; *(f32x4*)(fb + (size_t)lr * 1024 + c8 + 4) = v1;
                    u32x4 w; w.x = cvtpk(v0[0], v0[1]); w.y = cvtpk(v0[2], v0[3]); w.z = cvtpk(v1[0], v1[1]); w.w = cvtpk(v1[2], v1[3]);
                    *(u32x4*)(bb + (size_t)lr * 1024 + c8) = w; } }
    }
};
struct EpiResid {
    static constexpr bool PERM = false;
    const float* base0; const float* base1; float* out;
    __device__ __forceinline__ void operator()(const f32x4 (&acc)[2][2][4][2], const Unit& u, int wr, int wc, int fr, int fq) const {
#pragma unroll
        for (int ai = 0; ai < 2; ++ai)
#pragma unroll
            for (int m = 0; m < 4; ++m) { const int grow = u.pm * 256 + ai * 128 + wr * 64 + m * 16 + fr;
                const float* bp = (u.pm < 64) ? base0 + (size_t)grow * DM : base1 + (size_t)(grow - SEQ) * DM; float* op = out + (size_t)grow * DM;
#pragma unroll
                for (int bj = 0; bj < 2; ++bj)
#pragma unroll
                    for (int n = 0; n < 2; ++n) { const int col = u.pn * 256 + bj * 128 + wc * 32 + n * 16 + fq * 4;
                        const f32x4 b = *(const f32x4*)(bp + col); *(f32x4*)(op + col) = b * ALPHA + acc[ai][bj][m][n]; } }
    }
};
struct EpiBf16S {
    static constexpr bool PERM = true;
    bf16_t* O; int ldc; float scale;
    __device__ __forceinline__ void operator()(const f32x4 (&acc)[2][2][4][2], const Unit& u, int wr, int wc, int fr, int fq) const {
#pragma unroll
        for (int ai = 0; ai < 2; ++ai)
#pragma unroll
            for (int m = 0; m < 4; ++m) { const int grow = u.pm * 256 + ai * 128 + wr * 64 + m * 16 + fr;
#pragma unroll
                for (int bj = 0; bj < 2; ++bj) { const f32x4 v0 = acc[ai][bj][m][0] * scale, v1 = acc[ai][bj][m][1] * scale;
                    const int c8 = u.pn * 256 + bj * 128 + wc * 32 + fq * 8;
                    u32x4 w; w.x = cvtpk(v0[0], v0[1]); w.y = cvtpk(v0[2], v0[3]); w.z = cvtpk(v1[0], v1[1]); w.w = cvtpk(v1[2], v1[3]);
                    *(u32x4*)(O + (size_t)grow * ldc + c8) = w; } }
    }
};
template <bool SAMPLE> struct EpiUpConv {
    static constexpr bool PERM = true;
    bf16_t* H; const float* cw; const float* cb; const float* state; float* convp; float* convs;
    __device__ __forceinline__ void operator()(const f32x4 (&acc)[2][2][4][2], const Unit& u, int wr, int wc, int fr, int fq) const {
        const int lane = threadIdx.x & 63;
        const int src1 = (lane & 48) | ((lane - 1) & 15), src2 = (lane & 48) | ((lane - 2) & 15);
#pragma unroll
        for (int n = 0; n < 2; ++n) {
            const int gcol = u.pn * 128 + wc * 32 + fq * 8 + 4 * n;
            const f32x4 w0g = *(const f32x4*)(cw + gcol), w1g = *(const f32x4*)(cw + DFF2 + gcol), w2g = *(const f32x4*)(cw + 2 * DFF2 + gcol), bg = *(const f32x4*)(cb + gcol);
            const f32x4 w0v = *(const f32x4*)(cw + DFF + gcol), w1v = *(const f32x4*)(cw + DFF2 + DFF + gcol), w2v = *(const f32x4*)(cw + 2 * DFF2 + DFF + gcol), bv = *(const f32x4*)(cb + DFF + gcol);
#pragma unroll
            for (int ai = 0; ai < 2; ++ai)
#pragma unroll
                for (int m = 0; m < 4; ++m) {
                    const int lr = ai * 128 + wr * 64 + m * 16 + fr, rho = m * 16 + fr;
                    const f32x4 ug = acc[ai][0][m][n], uv = acc[ai][1][m][n];
                    const f32x4 pg = (m > 0) ? acc[ai][0][m - 1][n] : ug, pv = (m > 0) ? acc[ai][1][m - 1][n] : uv;
                    f32x4 t1g, t2g, t1v, t2v, p1g, p2g, p1v, p2v;
#pragma unroll
                    for (int j = 0; j < 4; ++j) { t1g[j] = (fr == 15) ? pg[j] : ug[j]; t2g[j] = (fr >= 14) ? pg[j] : ug[j]; t1v[j] = (fr == 15) ? pv[j] : uv[j]; t2v[j] = (fr >= 14) ? pv[j] : uv[j]; }
#pragma unroll
                    for (int j = 0; j < 4; ++j) { p1g[j] = __shfl(t1g[j], src1); p2g[j] = __shfl(t2g[j], src2); p1v[j] = __shfl(t1v[j], src1); p2v[j] = __shfl(t2v[j], src2); }
                    int grow; bool valid;
                    if (SAMPLE) {
                        grow = SEQ + lr; valid = true;
                        if ((m & 1) == 0) {
                            const int b = lr >> 5;
                            if (fr < 2) { const float* s0 = state + (size_t)(b * 2) * DFF2 + gcol; const float* s1 = s0 + DFF2;
                                const f32x4 s0g = *(const f32x4*)s0, s1g = *(const f32x4*)s1, s0v = *(const f32x4*)(s0 + DFF), s1v = *(const f32x4*)(s1 + DFF);
                                if (fr == 0) { p1g = s1g; p2g = s0g; p1v = s1v; p2v = s0v; } else { p2g = s1g; p2v = s1v; } }
                        }
                        const int t = lr & 31;
                        if (t >= 30) { float* cp = convs + (size_t)((lr >> 5) * 2 + (t - 30)) * DFF2 + gcol; *(f32x4*)cp = ug; *(f32x4*)(cp + DFF) = uv; }
                    } else {
                        grow = 62 * (4 * u.pm + 2 * ai + wr) + rho - 2; valid = (rho >= 2) && (grow < SEQ);
                        if (valid && grow >= SEQ - 2) { float* cp = convp + (size_t)(grow - (SEQ - 2)) * DFF2 + gcol; *(f32x4*)cp = ug; *(f32x4*)(cp + DFF) = uv; }
                    }
                    const f32x4 cg = w2g * ug + w1g * p1g + w0g * p2g + bg, cv = w2v * uv + w1v * p1v + w0v * p2v + bv;
                    f32x4 h;
#pragma unroll
                    for (int j = 0; j < 4; ++j) h[j] = cg[j] * __builtin_amdgcn_rcpf(1.f + __builtin_amdgcn_exp2f(-LOG2E * cg[j])) * cv[j];
                    if (valid) { u32x2 w; w.x = cvtpk(h[0], h[1]); w.y = cvtpk(h[2], h[3]); *(u32x2*)(H + (size_t)grow * DFF + gcol) = w; }
                }
        }
    }
};
}

__device__ __forceinline__ int crow(int r, int hi) { return (r & 3) + 8 * (r >> 2) + 4 * hi; }
typedef short v4i16_t __attribute__((ext_vector_type(4)));
__device__ __forceinline__ s16x4 vtr(const LAS unsigned char* p) { return __builtin_bit_cast(s16x4, __builtin_amdgcn_ds_read_tr16_b64_v4i16((LAS v4i16_t*)p)); }
template <int DQ, bool BIAS>
__device__ __forceinline__ void gsa_wave(const bf16_t* Q, int qp, const bf16_t* K, int kp, const bf16_t* V, int vp, int nkeys, const float* btab, int relbase,
                                         bf16_t* O, int op, LAS unsigned char* wl, int lane) {
    const int r32 = lane & 31, hi = lane >> 5;
    LAS float* wsf = (LAS float*)(wl + 4096);
    bf16x8 qr[DQ / 16];
#pragma unroll
    for (int d0 = 0; d0 < DQ / 16; ++d0) qr[d0] = *(const bf16x8*)(Q + (size_t)r32 * qp + d0 * 16 + hi * 8);
    f32x16 o0 = {}, o1 = {};
    float mrun = -INFINITY, l = 0.f;
    const LAS unsigned char* vb = wl + (4 * hi + ((lane & 15) >> 2)) * 64 + ((lane >> 4) & 1) * 32 + (lane & 3) * 8;
    for (int k0 = 0; k0 < nkeys; k0 += 32) {
        u32x4 vreg[4];
#pragma unroll
        for (int i = 0; i < 4; ++i) { const int idx = i * 64 + lane, key = idx >> 3, ch = idx & 7; vreg[i] = *(const u32x4*)(V + (size_t)(k0 + key) * vp + ch * 8); }
        f32x16 s = {};
#pragma unroll
        for (int d0 = 0; d0 < DQ / 16; ++d0) { const bf16x8 kf = *(const bf16x8*)(K + (size_t)(k0 + r32) * kp + d0 * 16 + hi * 8); s = __builtin_amdgcn_mfma_f32_32x32x16_bf16(kf, qr[d0], s, 0, 0, 0); }
#pragma unroll
        for (int i = 0; i < 4; ++i) { const int idx = i * 64 + lane, key = idx >> 3, ch = idx & 7; *(LAS u32x4*)(wl + ((ch >> 2) * 2 + (key >> 4)) * 1024 + (key & 15) * 64 + (ch & 3) * 16) = vreg[i]; }
        if (BIAS) {
#pragma unroll
            for (int r = 0; r < 16; ++r) s[r] += btab[relbase + r32 - (k0 + crow(r, hi))];
        }
        float mx = s[0];
#pragma unroll
        for (int r = 1; r < 16; ++r) mx = fmaxf(mx, s[r]);
        mx = fmaxf(mx, __shfl_xor(mx, 32));
        const float mnew = fmaxf(mrun, mx), alpha = __builtin_amdgcn_exp2f(mrun - mnew);
        float rs = 0.f;
#pragma unroll
        for (int r = 0; r < 16; ++r) { s[r] = __builtin_amdgcn_exp2f(s[r] - mnew); rs += s[r]; }
        rs += __shfl_xor(rs, 32);
        l = l * alpha + rs; mrun = mnew;
        if (hi == 0) wsf[r32] = alpha;
        asm volatile("s_waitcnt lgkmcnt(0)" ::: "memory");
#pragma unroll
        for (int g = 0; g < 4; ++g) { const f32x4 a4 = *(const LAS f32x4*)(wsf + 8 * g + 4 * hi);
#pragma unroll
            for (int j = 0; j < 4; ++j) { o0[4 * g + j] *= a4[j]; o1[4 * g + j] *= a4[j]; } }
        u32x4 pw0, pw1;
        pw0.x = cvtpk(s[0], s[1]); pw0.y = cvtpk(s[2], s[3]); pw0.z = cvtpk(s[4], s[5]); pw0.w = cvtpk(s[6], s[7]);
        pw1.x = cvtpk(s[8], s[9]); pw1.y = cvtpk(s[10], s[11]); pw1.z = cvtpk(s[12], s[13]); pw1.w = cvtpk(s[14], s[15]);
#pragma unroll
        for (int d0 = 0; d0 < 2; ++d0)
#pragma unroll
            for (int ks = 0; ks < 2; ++ks) {
                const s16x4 lo = vtr(vb + (d0 * 2 + ks) * 1024), hh = vtr(vb + (d0 * 2 + ks) * 1024 + 512);
                const bf16x8 vf = {lo[0], lo[1], lo[2], lo[3], hh[0], hh[1], hh[2], hh[3]};
                const bf16x8 pa = __builtin_bit_cast(bf16x8, ks == 0 ? pw0 : pw1);
                if (d0 == 0) o0 = __builtin_amdgcn_mfma_f32_32x32x16_bf16(pa, vf, o0, 0, 0, 0); else o1 = __builtin_amdgcn_mfma_f32_32x32x16_bf16(pa, vf, o1, 0, 0, 0);
            }
        asm volatile("s_waitcnt lgkmcnt(0)" ::: "memory");
    }
    if (hi == 0) wsf[r32] = 1.f / l;
    asm volatile("s_waitcnt lgkmcnt(0)" ::: "memory");
#pragma unroll
    for (int r = 0; r < 16; ++r) { const int q = crow(r, hi); const float rl = wsf[q];
        O[(size_t)q * op + r32] = f2bf(o0[r] * rl); O[(size_t)q * op + 32 + r32] = f2bf(o1[r] * rl); }
    asm volatile("s_waitcnt lgkmcnt(0)" ::: "memory");
}


namespace attn_body {
constexpr int NW = 8, QBLK = 32, QB = QBLK * NW, KVBLK = 64;
#define SBAR() __builtin_amdgcn_sched_barrier(0)
constexpr int NSLOT = 3, SLOTB = 8192;
constexpr int LDS_K = 0, LDS_V = NSLOT * SLOTB, LDS_WS = 2 * NSLOT * SLOTB, LDS_OST = LDS_WS + NW * 64 * 4, LDS_BYTES = LDS_OST + NW * 4096;
__device__ __forceinline__ void glds16(const void* gsrc, unsigned lds_dst) { unsigned keep;
  asm volatile("s_mov_b32 %0, m0\n\ts_mov_b32 m0, %2\n\ts_nop 0\n\tglobal_load_lds_dwordx4 %1, off\n\ts_mov_b32 m0, %0" : "=&s"(keep) : "v"(gsrc), "s"(lds_dst) : "memory"); }
__device__ __forceinline__ float max3f(float a, float b, float c) { float r; asm("v_max3_f32 %0, %1, %2, %3" : "=v"(r) : "v"(a), "v"(b), "v"(c)); return r; }
__device__ __forceinline__ float max2f(float a, float b) { float r; asm("v_max_f32_e32 %0, %1, %2" : "=v"(r) : "v"(a), "v"(b)); return r; }
__device__ __forceinline__ float fadd_s(float a, float b) { float r; asm("v_add_f32_e32 %0, %1, %2" : "=v"(r) : "v"(a), "v"(b)); return r; }
__device__ __forceinline__ float fsub_s(float a, float b) { float r; asm("v_sub_f32_e32 %0, %1, %2" : "=v"(r) : "v"(a), "v"(b)); return r; }
#define WAIT_BAR(N) asm volatile("s_waitcnt vmcnt(" #N ") lgkmcnt(0)\n\ts_barrier" ::: "memory")
__device__ __forceinline__ void qkt(f32x16& p0, f32x16& p1, const char* Kslot, const bf16x8* qr, const f32x16& negm, int r32, int hi) {
  const char* kb = Kslot + hi * 1024 + r32 * 16;
  #pragma unroll
  for (int d0 = 0; d0 < 4; ++d0) {
    const bf16x8 b0 = *reinterpret_cast<const bf16x8*>(kb + d0 * 2048);
    const bf16x8 b1 = *reinterpret_cast<const bf16x8*>(kb + d0 * 2048 + 512);
    if (d0 == 0) { p0 = __builtin_amdgcn_mfma_f32_32x32x16_bf16(b0, qr[0], negm, 0, 0, 0); p1 = __builtin_amdgcn_mfma_f32_32x32x16_bf16(b1, qr[0], negm, 0, 0, 0); }
    else { p0 = __builtin_amdgcn_mfma_f32_32x32x16_bf16(b0, qr[d0], p0, 0, 0, 0); p1 = __builtin_amdgcn_mfma_f32_32x32x16_bf16(b1, qr[d0], p1, 0, 0, 0); } }
}
typedef __attribute__((address_space(3))) const char* lds_cptr;
__device__ __forceinline__ void kload8(bf16x8* kf, lds_cptr kp) {
  kf[0] = *(const LAS bf16x8*)(kp);        kf[1] = *(const LAS bf16x8*)(kp + 512);
  kf[2] = *(const LAS bf16x8*)(kp + 2048); kf[3] = *(const LAS bf16x8*)(kp + 2560);
  kf[4] = *(const LAS bf16x8*)(kp + 4096); kf[5] = *(const LAS bf16x8*)(kp + 4608);
  kf[6] = *(const LAS bf16x8*)(kp + 6144); kf[7] = *(const LAS bf16x8*)(kp + 6656);
}
__device__ __forceinline__ void kload2(bf16x8* kf, lds_cptr kp, int j) { kf[2 * j] = *(const LAS bf16x8*)(kp + j * 2048); kf[2 * j + 1] = *(const LAS bf16x8*)(kp + j * 2048 + 512); }
__device__ __forceinline__ s16x4 vtr(lds_cptr p) { return __builtin_bit_cast(s16x4, __builtin_amdgcn_ds_read_tr16_b64_v4i16((LAS v4i16_t*)p)); }
__device__ __forceinline__ float rowmax(const f32x16& p0, const f32x16& p1) {
  float a = max3f(p0[0], p0[1], p1[0]), b = max3f(p0[2], p0[3], p1[1]); a = max3f(a, p1[2], p1[3]);
  #pragma unroll
  for (int r = 4; r < 16; r += 4) { a = max3f(a, p0[r], p0[r + 1]); b = max3f(b, p0[r + 2], p0[r + 3]); a = max3f(a, p1[r], p1[r + 1]); b = max3f(b, p1[r + 2], p1[r + 3]); }
  const float m = max2f(a, b);
  auto rr = __builtin_amdgcn_permlane32_swap(__float_as_uint(m), __float_as_uint(m), false, false);
  return max2f(__uint_as_float(rr[0]), __uint_as_float(rr[1]));
}
__device__ __forceinline__ void pv(f32x16* o, int vb, bf16x8 pa0, bf16x8 pa1, bf16x8 pa2, bf16x8 pa3) {
  #pragma unroll
  for (int d0 = 0; d0 < 2; ++d0) { s16x4 lo[4], hi[4];
    #pragma unroll
    for (int ks = 0; ks < 4; ++ks) {
      asm volatile("ds_read_b64_tr_b16 %0,%1 offset:%c2" : "=&v"(lo[ks]) : "v"(vb), "i"(d0 * 4096 + ks * 1024) : "memory");
      asm volatile("ds_read_b64_tr_b16 %0,%1 offset:%c2" : "=&v"(hi[ks]) : "v"(vb), "i"(d0 * 4096 + ks * 1024 + 512) : "memory"); }
    asm volatile("s_waitcnt lgkmcnt(0)" ::: "memory"); SBAR();
    #define PK(k) (bf16x8){lo[k][0], lo[k][1], lo[k][2], lo[k][3], hi[k][0], hi[k][1], hi[k][2], hi[k][3]}
    o[d0] = __builtin_amdgcn_mfma_f32_32x32x16_bf16(pa0, PK(0), o[d0], 0, 0, 0);
    o[d0] = __builtin_amdgcn_mfma_f32_32x32x16_bf16(pa1, PK(1), o[d0], 0, 0, 0);
    o[d0] = __builtin_amdgcn_mfma_f32_32x32x16_bf16(pa2, PK(2), o[d0], 0, 0, 0);
    o[d0] = __builtin_amdgcn_mfma_f32_32x32x16_bf16(pa3, PK(3), o[d0], 0, 0, 0);
    #undef PK
  }
}
template <int THRL> __device__ __forceinline__ void attn_unit(int qb, const bf16_t* Qh, const bf16_t* __restrict__ Kh, const bf16_t* __restrict__ Vh, const int PQ, bf16_t* Oh, const int PO, char* shm) {
  const int tid = threadIdx.x, lane = tid & 63, r32 = lane & 31, hi = lane >> 5; const int wid = __builtin_amdgcn_readfirstlane(tid >> 6);
  const int q0 = qb * QB;
  const bf16_t* Qw = Qh + (long)(q0 + wid * QBLK) * PQ;
  const unsigned lds0 = (unsigned)(uintptr_t)shm;
  float* wsf = (float*)(shm + LDS_WS) + wid * 64;
  const bf16_t* ksrc = Kh + (long)lane * PQ + wid * 8;
  const bf16_t* vsrc = Vh + (long)(16 * (wid & 3) + (lane >> 2)) * PQ + (wid >> 2) * 32 + (lane & 3) * 8;
  const unsigned kdst = lds0 + LDS_K + wid * 1024, vdst = lds0 + LDS_V + wid * 1024;
  #define DMA_K(t, slot) glds16(ksrc + (long)(t) * KVBLK * PQ, (unsigned)__builtin_amdgcn_readfirstlane(kdst + (slot)))
  #define DMA_V(t, slot) glds16(vsrc + (long)(t) * KVBLK * PQ, (unsigned)__builtin_amdgcn_readfirstlane(vdst + (slot)))
  const int vb0 = (int)(lds0 + LDS_V) + ((lane >> 4) & 1) * 32 + (lane & 3) * 8 + (4 * hi + ((lane & 15) >> 2)) * 64;
  const char* Kbase = shm + LDS_K; bf16x8 kf[8];
  const lds_cptr shm3 = (lds_cptr)shm; const lds_cptr kp0 = shm3 + LDS_K + hi * 1024 + r32 * 16; const lds_cptr vp0 = shm3 + LDS_V + ((lane >> 4) & 1) * 32 + (lane & 3) * 8 + (4 * hi + ((lane & 15) >> 2)) * 64;
  const int NT = (q0 + QB) / KVBLK;
  DMA_K(0, 0); DMA_V(0, 0); DMA_K(1, SLOTB);
  bf16x8 qr[4];
  #pragma unroll
  for (int d0 = 0; d0 < 4; ++d0) qr[d0] = *reinterpret_cast<const bf16x8*>(&Qw[(long)r32 * PQ + d0 * 16 + hi * 8]);
  float mhat = 0.f, l_reg = 0.f; f32x16 o[2]; o[0] = f32x16{}; o[1] = f32x16{}; f32x16 negm = f32x16{}; asm volatile("" : "+v"(negm));
  const int wchunk = wid >> 1;
  #define CMASK(P0, P1, t) do { int jb_ = (t) - (NT - 4); if (jb_ > wchunk) { _Pragma("unroll") for (int r_ = 0; r_ < 16; ++r_) { P0[r_] = -INFINITY; P1[r_] = -INFINITY; } } } while (0)
  bool resc = false;
  #define START(P0, P1) do { const float rm = rowmax(P0, P1); resc = false; \
    { const float dl = rm; mhat = fadd_s(mhat, dl); \
      _Pragma("unroll") for (int r = 0; r < 16; ++r) { P0[r] = fsub_s(P0[r], dl); P1[r] = fsub_s(P1[r], dl); } \
      _Pragma("unroll") for (int r = 0; r < 16; ++r) negm[r] = -mhat; asm volatile("" : "+v"(negm)); } \
    _Pragma("unroll") for (int r = 0; r < 16; ++r) P0[r] = __builtin_amdgcn_exp2f(P0[r]); } while (0)
  #define RESC() do { if (resc) { asm volatile("s_waitcnt lgkmcnt(0)" ::: "memory"); \
      _Pragma("unroll") for (int d_ = 0; d_ < 2; ++d_) _Pragma("unroll") for (int r = 0; r < 16; ++r) o[d_][r] *= wsf[crow(r, hi)]; } } while (0)
  f32x16 pA0, pA1, pB0, pB1;
  int sl_prev = 0, sl_cur = 0, sl_next = SLOTB;
  #define ROT() do { sl_prev = sl_cur; sl_cur = sl_next; sl_next = (sl_next == (NSLOT - 1) * SLOTB) ? 0 : sl_next + SLOTB; } while (0)
  DMA_K(2, 2 * SLOTB);
  WAIT_BAR(3);
  qkt(pA0, pA1, Kbase, qr, negm, r32, hi); asm volatile("s_nop 15\n\ts_nop 7" : "+v"(pA0), "+v"(pA1)); CMASK(pA0, pA1, 0);
  START(pA0, pA1);
  _Pragma("unroll") for (int r = 0; r < 16; ++r) pA1[r] = __builtin_amdgcn_exp2f(pA1[r]);
  WAIT_BAR(0);
  DMA_K(3, 0); DMA_V(1, SLOTB);
  ROT();
  kload8(kf, kp0 + sl_cur);
  WAIT_BAR(2);
  s16x4 vlo[8], vhi[8]; u32x4 pw0, pw1, pw2, pw3;
  #define PKW(P, B) cvtpk(P[B], P[B + 1])
  #define PAF(k) __builtin_bit_cast(bf16x8, pw##k)
  #define VFR(i) (bf16x8){vlo[i][0], vlo[i][1], vlo[i][2], vlo[i][3], vhi[i][0], vhi[i][1], vhi[i][2], vhi[i][3]}
  #define PIN(x) asm volatile("" : "+v"(x))
  #define MX3(a, b, c) __builtin_fmaxf(__builtin_fmaxf((a), (b)), (c))
  #define GAPA(MF, A0, A1, A2, A3, W0, W1, PW) do { MF; sacc += A0; sacc += A1; sacc += A2; sacc += A3; PIN(sacc); W0; W1; PIN(PW); SBAR(); } while (0)
  #define EX(v) __builtin_amdgcn_exp2f(v)
  #define GAPB(MF, X, B) do { MF; X[B] = EX(X[B]); X[B + 1] = EX(X[B + 1]); X[B + 2] = EX(X[B + 2]); X[B + 3] = EX(X[B + 3]); PIN(X); SBAR(); } while (0)
  #define VRD(i) do { vlo[i] = vtr(vp_ + (((i) >> 2) * 4096 + ((i) & 3) * 1024)); vhi[i] = vtr(vp_ + (((i) >> 2) * 4096 + ((i) & 3) * 1024 + 512)); } while (0)
  #define KRD(G, j) do { if (G) { kload2(kf, kp0 + sl_next, j); SBAR(); } } while (0)
  #define STEP(C0, C1, P0, P1, t, GK, GV, GL) do { SBAR(); \
    const lds_cptr vp_ = vp0 + sl_prev; \
    VRD(0); SBAR(); float sacc = (P0[0] + P0[1]); \
    GAPA(C0 = __builtin_amdgcn_mfma_f32_32x32x16_bf16(kf[0], qr[0], negm, 0, 0, 0), P0[2], P0[3], P0[4], P0[5],     pw0[0] = PKW(P0, 0), pw0[1] = PKW(P0, 2), pw0); \
    VRD(4); SBAR(); GAPA(C1 = __builtin_amdgcn_mfma_f32_32x32x16_bf16(kf[1], qr[0], negm, 0, 0, 0), P0[6], P0[7], P0[8], P0[9],     pw0[2] = PKW(P0, 4), pw0[3] = PKW(P0, 6), pw0); \
    VRD(1); SBAR(); GAPA(C0 = __builtin_amdgcn_mfma_f32_32x32x16_bf16(kf[2], qr[1], C0, 0, 0, 0),   P0[10], P0[11], P0[12], P0[13], pw1[0] = PKW(P0, 8), pw1[1] = PKW(P0, 10), pw1); \
    VRD(5); SBAR(); GAPA(C1 = __builtin_amdgcn_mfma_f32_32x32x16_bf16(kf[3], qr[1], C1, 0, 0, 0),   P0[14], P0[15], P1[0], P1[1],   pw1[2] = PKW(P0, 12), pw1[3] = PKW(P0, 14), pw1); \
    VRD(2); SBAR(); GAPA(C0 = __builtin_amdgcn_mfma_f32_32x32x16_bf16(kf[4], qr[2], C0, 0, 0, 0),   P1[2], P1[3], P1[4], P1[5],     pw2[0] = PKW(P1, 0), pw2[1] = PKW(P1, 2), pw2); \
    VRD(6); SBAR(); GAPA(C1 = __builtin_amdgcn_mfma_f32_32x32x16_bf16(kf[5], qr[2], C1, 0, 0, 0),   P1[6], P1[7], P1[8], P1[9],     pw2[2] = PKW(P1, 4), pw2[3] = PKW(P1, 6), pw2); \
    VRD(3); SBAR(); GAPA(C0 = __builtin_amdgcn_mfma_f32_32x32x16_bf16(kf[6], qr[3], C0, 0, 0, 0),   P1[10], P1[11], P1[12], P1[13], pw3[0] = PKW(P1, 8), pw3[1] = PKW(P1, 10), pw3); \
    VRD(7); SBAR(); GAPA(C1 = __builtin_amdgcn_mfma_f32_32x32x16_bf16(kf[7], qr[3], C1, 0, 0, 0),   P1[14], P1[15], 0.f, 0.f,       pw3[2] = PKW(P1, 12), pw3[3] = PKW(P1, 14), pw3); \
    l_reg += sacc; \
    if (GK) { DMA_K((t) + 3, sl_cur); } if (GV) { DMA_V((t) + 1, sl_next); } \
    CMASK(C0, C1, t); \
    { float a = MX3(C0[0], C0[1], C1[0]), b = MX3(C0[2], C0[3], C1[1]); a = MX3(a, C1[2], C1[3]); \
      _Pragma("unroll") for (int r = 4; r < 16; r += 4) { a = MX3(a, C0[r], C0[r + 1]); b = MX3(b, C0[r + 2], C0[r + 3]); a = MX3(a, C1[r], C1[r + 1]); b = MX3(b, C1[r + 2], C1[r + 3]); } \
      float rm = __builtin_fmaxf(a, b); { auto rr = __builtin_amdgcn_permlane32_swap(__float_as_uint(rm), __float_as_uint(rm), false, false); rm = __builtin_fmaxf(__uint_as_float(rr[0]), __uint_as_float(rr[1])); } \
      resc = false; \
      if (__builtin_expect(__any(rm > (float)THRL), 0)) { const float dl = __builtin_fmaxf(rm, 0.f); mhat += dl; \
        _Pragma("unroll") for (int r = 0; r < 16; ++r) { C0[r] -= dl; C1[r] -= dl; } \
        _Pragma("unroll") for (int r = 0; r < 16; ++r) negm[r] = -mhat; asm volatile("" : "+v"(negm)); \
        const float f = __builtin_amdgcn_exp2f(-dl); l_reg *= f; if (hi == 0) wsf[r32] = f; resc = true; } } \
    SBAR(); \
    GAPB(o[0] = __builtin_amdgcn_mfma_f32_32x32x16_bf16(PAF(0), VFR(0), o[0], 0, 0, 0), C0, 0); \
    GAPB(o[1] = __builtin_amdgcn_mfma_f32_32x32x16_bf16(PAF(0), VFR(4), o[1], 0, 0, 0), C0, 4); \
    KRD(GL, 0); GAPB(o[0] = __builtin_amdgcn_mfma_f32_32x32x16_bf16(PAF(1), VFR(1), o[0], 0, 0, 0), C0, 8); \
    KRD(GL, 1); GAPB(o[1] = __builtin_amdgcn_mfma_f32_32x32x16_bf16(PAF(1), VFR(5), o[1], 0, 0, 0), C0, 12); \
    KRD(GL, 2); GAPB(o[0] = __builtin_amdgcn_mfma_f32_32x32x16_bf16(PAF(2), VFR(2), o[0], 0, 0, 0), C1, 0); \
    KRD(GL, 3); GAPB(o[1] = __builtin_amdgcn_mfma_f32_32x32x16_bf16(PAF(2), VFR(6), o[1], 0, 0, 0), C1, 4); \
    GAPB(o[0] = __builtin_amdgcn_mfma_f32_32x32x16_bf16(PAF(3), VFR(3), o[0], 0, 0, 0), C1, 8); \
    GAPB(o[1] = __builtin_amdgcn_mfma_f32_32x32x16_bf16(PAF(3), VFR(7), o[1], 0, 0, 0), C1, 12); \
    } while (0)
  int t = 1;
  #undef CMASK
  #define CMASK(P0, P1, t) do {} while (0)
  for (; t + 5 < NT; t += 2) {
    STEP(pB0, pB1, pA0, pA1, t, true, true, true);     WAIT_BAR(2); RESC(); ROT();
    STEP(pA0, pA1, pB0, pB1, t + 1, true, true, true); WAIT_BAR(2); RESC(); ROT();
  }
  #undef CMASK
  #define CMASK(P0, P1, t) do { int jb_ = (t) - (NT - 4); if (jb_ > wchunk) { _Pragma("unroll") for (int r_ = 0; r_ < 16; ++r_) { P0[r_] = -INFINITY; P1[r_] = -INFINITY; } } } while (0)
  #define ENDW(tt) do { if ((tt) + 3 < NT) { WAIT_BAR(2); } else if ((tt) + 2 < NT) { WAIT_BAR(1); } else { WAIT_BAR(0); } } while (0)
  for (; t + 1 < NT; t += 2) {
    STEP(pB0, pB1, pA0, pA1, t, (t + 3 < NT), (t + 1 < NT), (t + 1 < NT));         ENDW(t);     RESC(); ROT();
    STEP(pA0, pA1, pB0, pB1, t + 1, (t + 4 < NT), (t + 2 < NT), (t + 2 < NT));     ENDW(t + 1); RESC(); ROT();
  }
  STEP(pB0, pB1, pA0, pA1, NT - 1, false, false, false); RESC();
  { float sacc = pB0[0] + pB0[1]; _Pragma("unroll") for (int r = 2; r < 16; ++r) sacc += pB0[r]; _Pragma("unroll") for (int r = 0; r < 16; ++r) sacc += pB1[r]; l_reg += sacc;
    pw0 = (u32x4){PKW(pB0, 0), PKW(pB0, 2), PKW(pB0, 4), PKW(pB0, 6)}; pw1 = (u32x4){PKW(pB0, 8), PKW(pB0, 10), PKW(pB0, 12), PKW(pB0, 14)}; pw2 = (u32x4){PKW(pB1, 0), PKW(pB1, 2), PKW(pB1, 4), PKW(pB1, 6)}; pw3 = (u32x4){PKW(pB1, 8), PKW(pB1, 10), PKW(pB1, 12), PKW(pB1, 14)};
    SBAR(); pv(o, vb0 + sl_cur, PAF(0), PAF(1), PAF(2), PAF(3)); }
  #undef PKW
  #undef PAF
  #undef VFR
  #undef PIN
  #undef MX3
  #undef GAPA
  #undef GAPB
  #undef EX
  #undef VRD
  #undef KRD
  #undef STEP
  #undef ENDW
  { auto rr = __builtin_amdgcn_permlane32_swap(__float_as_uint(l_reg), __float_as_uint(l_reg), false, false); l_reg = __uint_as_float(rr[0]) + __uint_as_float(rr[1]); }
  if (hi == 0) wsf[32 + r32] = l_reg; asm volatile("s_waitcnt lgkmcnt(0)" ::: "memory");
  float rli[16];
  #pragma unroll
  for (int r = 0; r < 16; ++r) rli[r] = __builtin_amdgcn_rcpf(wsf[32 + crow(r, hi)]);
  bf16_t* Ow = Oh + (long)(q0 + wid * QBLK) * PO;
  { bf16_t* stg = (bf16_t*)(shm + LDS_OST) + wid * 2048;
    #pragma unroll
    for (int r = 0; r < 16; ++r) { const int orow = crow(r, hi);
      #pragma unroll
      for (int d0 = 0; d0 < 2; ++d0) stg[orow * 64 + d0 * 32 + r32] = f2bf(o[d0][r] * rli[r]); }
    asm volatile("s_waitcnt lgkmcnt(0)" ::: "memory");
    #pragma unroll
    for (int i = 0; i < 4; ++i) { const int row = i * 8 + (lane >> 3), ch = lane & 7; const u32x4 v = *(const u32x4*)(stg + row * 64 + ch * 8); *(u32x4*)(Ow + (long)row * PO + ch * 8) = v; } }
  asm volatile("s_waitcnt lgkmcnt(0)\n\ts_barrier" ::: "memory");
  #undef DMA_K
  #undef DMA_V
  #undef CMASK
  #undef START
  #undef RESC
  #undef ROT
}
#undef SBAR
#undef WAIT_BAR
}

typedef GAS unsigned gu32;
#define RLX_AGENT __ATOMIC_RELAXED, __HIP_MEMORY_SCOPE_AGENT
#define XB_TMO      128
#define XB_XCNT(j)  (256  + 64 * (j))
#define XB_XSUB(j)  (1280 + 64 * (j))
#define XB_XGEN(j)  (2304 + 64 * (j))
#define XB_TOP      3328
#define XB_TOPGEN   3392
#define XCD_BAR_WORDS 3456
#define XB_SPIN_CAP (1u << 18)
__device__ __forceinline__ unsigned xb_ld(unsigned* p)              { return __hip_atomic_load(p, __ATOMIC_RELAXED, __HIP_MEMORY_SCOPE_AGENT); }
__device__ __forceinline__ unsigned xb_add(unsigned* p, unsigned v) { return __hip_atomic_fetch_add(p, v, __ATOMIC_RELAXED, __HIP_MEMORY_SCOPE_AGENT); }
__device__ __forceinline__ unsigned xb_xcc_id() { return (unsigned)__builtin_amdgcn_s_getreg((3 << 11) | 20) & 0xFu; }
#define XB_SPIN(cond, bar) do { unsigned _sp = 0; while (cond) { __builtin_amdgcn_s_sleep(1); \
    if ((++_sp & 255u) == 0u) { if (xb_ld(&(bar)[XB_TMO])) break; if (_sp > XB_SPIN_CAP) { atomicAdd(&(bar)[XB_TMO], 1u); break; } } } } while (0)
struct XcdBarrier { unsigned* bar; unsigned x; volatile LAS unsigned* st; };
__device__ __forceinline__ XcdBarrier xcd_barrier_post(unsigned* bar, volatile LAS unsigned* st) {
    XcdBarrier b; b.bar = bar; b.x = xb_xcc_id(); b.st = st;
    if (threadIdx.x == 0) (void)xb_add(&bar[XB_XCNT(b.x)], 1u);
    return b;
}
__device__ __forceinline__ void xcd_barrier_complete(unsigned* bar, unsigned x, unsigned& nloc, unsigned& nx) {
    const unsigned G = gridDim.x * gridDim.y * gridDim.z;
    unsigned sum, cnt, mine, sp = 0u;
    for (;;) {
        sum = 0u; cnt = 0u; mine = 0u;
#pragma unroll
        for (unsigned j = 0; j < 16; ++j) { const unsigned c = xb_ld(&bar[XB_XCNT(j)]); sum += c; cnt += (c > 0u) ? 1u : 0u; mine = (j == x) ? c : mine; }
        if (sum == G) break;
        __builtin_amdgcn_s_sleep(1);
        if ((++sp & 255u) == 0u) { if (xb_ld(&bar[XB_TMO])) break; if (sp > XB_SPIN_CAP) { atomicAdd(&bar[XB_TMO], 1u); break; } }
    }
    nloc = mine > 0u ? mine : 1u; nx = cnt > 0u ? cnt : 1u;
}
__device__ __forceinline__ void xcd_barrier(const XcdBarrier& b) {
    asm volatile("s_waitcnt vmcnt(0)" ::: "memory");
    __syncthreads();
    if (threadIdx.x == 0) {
        unsigned* bar = b.bar;
        __builtin_amdgcn_s_waitcnt(0);
        unsigned nloc = b.st[0], nx = b.st[1];
        if (nloc == 0u) { xcd_barrier_complete(bar, b.x, nloc, nx); b.st[0] = nloc; b.st[1] = nx; }
        const unsigned old = xb_add(&bar[XB_XSUB(b.x)], 1u);
        const unsigned gen = old / nloc;
        if (old + 1u == (gen + 1u) * nloc) {
            __builtin_amdgcn_fence(__ATOMIC_RELEASE, "agent");
            asm volatile("s_waitcnt vmcnt(0)" ::: "memory");
            const unsigned og = xb_add(&bar[XB_TOP], 1u);
            const unsigned tg = og / nx;
            if (og + 1u == (tg + 1u) * nx) xb_add(&bar[XB_TOPGEN], 1u);
            else XB_SPIN(xb_ld(&bar[XB_TOPGEN]) == tg, bar);
            __builtin_amdgcn_fence(__ATOMIC_ACQUIRE, "agent");
            xb_add(&bar[XB_XGEN(b.x)], 1u);
            asm volatile("s_waitcnt vmcnt(0)" ::: "memory");
        } else {
            XB_SPIN(xb_ld(&bar[XB_XGEN(b.x)]) == gen, bar);
            __builtin_amdgcn_fence(__ATOMIC_ACQUIRE, "agent");
            asm volatile("s_waitcnt vmcnt(0)" ::: "memory");
        }
    }
    __syncthreads();
}

constexpr int NWAVES = 8;
constexpr int RING_BYTES = 131072, LDSCTL_OFF = RING_BYTES, MISC_OFF = LDSCTL_OFF + 320, LDS_BYTES = 147456;
constexpr int CW_BAR = 4096;
constexpr int NPHASE = 13;
#ifndef MK_N_LAUNCHES
#define MK_N_LAUNCHES 1
#endif
constexpr int N_LAUNCHES = MK_N_LAUNCHES;

#define LDS_WAIT() asm volatile("s_waitcnt lgkmcnt(0)" ::: "memory")
__device__ __forceinline__ float wave_sum(float v) {
#pragma unroll
    for (int o = 1; o < 64; o <<= 1) v += __shfl_xor(v, o);
    return v;
}
__device__ __forceinline__ void p0_transpose_item(const float* W, int K, int N, bf16_t* WT, int k0, int n0, int orow0, LAS float* scr, int lane) {
#pragma unroll 8
    for (int i = 0; i < 32; ++i) { const int kk = 2 * i + (lane >> 5); scr[kk * 33 + (lane & 31)] = W[(size_t)(k0 + kk) * N + n0 + (lane & 31)]; }
    LDS_WAIT(); asm volatile("" ::: "memory");
    const int c = lane & 7;
#pragma unroll
    for (int j = 0; j < 4; ++j) { const int n = (lane >> 3) + 8 * j; const LAS float* s = scr + (8 * c) * 33 + n;
        u32x4 o; o.x = cvtpk(s[0 * 33], s[1 * 33]); o.y = cvtpk(s[2 * 33], s[3 * 33]); o.z = cvtpk(s[4 * 33], s[5 * 33]); o.w = cvtpk(s[6 * 33], s[7 * 33]);
        *(u32x4*)(WT + (size_t)(orow0 + n) * K + k0 + 8 * c) = o; }
    LDS_WAIT(); asm volatile("" ::: "memory");
}
__device__ __forceinline__ void sincos_d(double a, double& s, double& c) {
    const double k = __builtin_rint(a * 0.63661977236758134308);
    double r = __builtin_fma(-k, 1.57079632679489655800e+00, a); r = __builtin_fma(-k, 6.12323399573676603587e-17, r);
    const double r2 = r * r;
    double sp = -7.6471637318198164759e-13; sp = sp * r2 + 1.6059043836821614599e-10; sp = sp * r2 - 2.5052108385441718775e-08; sp = sp * r2 + 2.7557319223985890653e-06;
    sp = sp * r2 - 1.9841269841269841270e-04; sp = sp * r2 + 8.3333333333333333333e-03; sp = sp * r2 - 1.6666666666666666667e-01; const double sr = r + r * r2 * sp;
    double cp = 4.7794773323873852974e-14; cp = cp * r2 - 1.1470745597729724714e-11; cp = cp * r2 + 2.0876756987868098979e-09; cp = cp * r2 - 2.7557319223985890653e-07;
    cp = cp * r2 + 2.4801587301587301587e-05; cp = cp * r2 - 1.3888888888888888889e-03; cp = cp * r2 + 4.1666666666666666667e-02; cp = cp * r2 - 0.5; const double cr = 1.0 + r2 * cp;
    const int q = ((int)k) & 3;
    s = (q == 0) ? sr : (q == 1) ? cr : (q == 2) ? -sr : -cr;
    c = (q == 0) ? cr : (q == 1) ? -sr : (q == 2) ? -cr : sr;
}

struct Args { const float* in[32]; float* out; unsigned char* ws; int ph_lo, ph_hi, li, pad; };

__global__ void __launch_bounds__(NWAVES * 64, 2) mk_fwd(Args args) {
    extern __shared__ __attribute__((aligned(16))) unsigned char lds_raw[];
    LAS unsigned char* lds = (LAS unsigned char*)lds_raw;
    volatile LAS unsigned* MISC = (volatile LAS unsigned*)(lds + MISC_OFF);
    const int tid = threadIdx.x, lane = tid & 63, wave = __builtin_amdgcn_readfirstlane(tid >> 6);
    const int G = gridDim.x, bx = blockIdx.x;
    const int gw = bx * NWAVES + wave, NGW = G * NWAVES;
    unsigned char* ws = args.ws; float* out = args.out;
    gu32* ctl = (gu32*)(ws + WS_CTL);
    for (int u = tid; u < (LDS_BYTES - LDSCTL_OFF) / 4; u += NWAVES * 64) ((LAS unsigned*)(lds + LDSCTL_OFF))[u] = 0u;
    __syncthreads();
    XcdBarrier bar; bar.bar = (unsigned*)(ctl + CW_BAR); bar.x = 0; bar.st = nullptr;
    if (N_LAUNCHES == 1) bar = xcd_barrier_post((unsigned*)(ctl + CW_BAR), MISC + 8);
#define GRID_BAR() do { if (N_LAUNCHES == 1) xcd_barrier(bar); } while (0)
    const int lo = args.ph_lo, hi_ph = args.ph_hi;
#define IN(k) (lo <= (k) && (k) < hi_ph)
#define SEAM(k) do { if (IN(k) && IN((k) + 1)) GRID_BAR(); } while (0)

    const float* x_prompt = args.in[0]; const float* x_sample = args.in[1]; const float* mem_prompt = args.in[2];
#define Wqkv_t ((bf16_t*)(ws + WS_WQKV))
#define Wo_t ((bf16_t*)(ws + WS_WO))
#define Wmq_t ((bf16_t*)(ws + WS_WMQ))
#define Wmkv_t ((bf16_t*)(ws + WS_WMKV))
#define Wmo_t ((bf16_t*)(ws + WS_WMO))
#define Wup_t ((bf16_t*)(ws + WS_WUP))
#define Wdn_t ((bf16_t*)(ws + WS_WDN))
#define MEMB ((bf16_t*)(ws + WS_MEMB))
#define MKB ((bf16_t*)(ws + WS_MKB))
#define MVB ((bf16_t*)(ws + WS_MVB))
#define KAS ((bf16_t*)(ws + WS_KAS))
#define VAS ((bf16_t*)(ws + WS_VAS))
#define KBS ((bf16_t*)(ws + WS_KBS))
#define VBS ((bf16_t*)(ws + WS_VBS))
#define MKS ((bf16_t*)(ws + WS_MKS))
#define MVS ((bf16_t*)(ws + WS_MVS))
#define QKVB ((bf16_t*)(ws + WS_QKVB))
#define XB ((bf16_t*)(ws + WS_XB))
#define OD ((bf16_t*)(ws + WS_OD))
#define MIXA ((bf16_t*)(ws + WS_MIXA))
#define X1B ((bf16_t*)(ws + WS_X1B))
#define X2B ((bf16_t*)(ws + WS_X2B))
#define QM ((bf16_t*)(ws + WS_QM))
#define OM ((bf16_t*)(ws + WS_OM))
#define HB ((bf16_t*)(ws + WS_H))
#define ROPE ((float*)(ws + WS_ROPE))
#define BT ((float*)(ws + WS_BT))
#define LAMP ((float*)(ws + WS_LAM))
    float* R = out + OFF_Y;

    if (IN(0)) {
        LAS float* scr = (LAS float*)(lds + wave * 16384);
        {
            constexpr int I_QKV = 16 * 96, I_SQ = 16 * 32, I_UP = 16 * 176, I_DN = 44 * 32;
            constexpr int NITEMS = I_QKV + 5 * I_SQ + I_UP + I_DN;
            for (int it = gw; it < NITEMS; it += NGW) {
                int r = it;
                if (r < I_QKV) { const int kb = r / 96, nb = r % 96; p0_transpose_item(args.in[10], 1024, 3072, Wqkv_t, kb * 64, nb * 32, nb * 32, scr, lane); continue; } r -= I_QKV;
                if (r < I_SQ) { const int kb = r / 32, nb = r % 32; p0_transpose_item(args.in[17], 1024, 1024, Wo_t, kb * 64, nb * 32, nb * 32, scr, lane); continue; } r -= I_SQ;
                if (r < I_SQ) { const int kb = r / 32, nb = r % 32; p0_transpose_item(args.in[20], 1024, 1024, Wmq_t, kb * 64, nb * 32, nb * 32, scr, lane); continue; } r -= I_SQ;
                if (r < I_SQ) { const int kb = r / 32, nb = r % 32; p0_transpose_item(args.in[21], 1024, 1024, Wmkv_t, kb * 64, nb * 32, nb * 32, scr, lane); continue; } r -= I_SQ;
                if (r < I_SQ) { const int kb = r / 32, nb = r % 32; p0_transpose_item(args.in[22], 1024, 1024, Wmkv_t, kb * 64, nb * 32, 1024 + nb * 32, scr, lane); continue; } r -= I_SQ;
                if (r < I_SQ) { const int kb = r / 32, nb = r % 32; p0_transpose_item(args.in[23], 1024, 1024, Wmo_t, kb * 64, nb * 32, nb * 32, scr, lane); continue; } r -= I_SQ;
                if (r < I_UP) { const int kb = r / 176, nb = r % 176, n0 = nb * 32, bj = n0 / DFF, f = n0 % DFF; p0_transpose_item(args.in[26], 1024, DFF2, Wup_t, kb * 64, n0, 256 * (f / 128) + 128 * bj + (f % 128), scr, lane); continue; } r -= I_UP;
                { const int kb = r / 32, nb = r % 32; p0_transpose_item(args.in[29], DFF, 1024, Wdn_t, kb * 64, nb * 32, nb * 32, scr, lane); }
            }
        }
        for (int m = gw; m < MROWS + 256; m += NGW) {
            const float* src = (m < SEQ) ? x_prompt + (size_t)m * DM : (m < MROWS) ? x_sample + (size_t)(m - SEQ) * DM : mem_prompt + (size_t)(m - MROWS) * DM;
            bf16_t* dst = (m < MROWS) ? XB + (size_t)m * DM : MEMB + (size_t)(m - MROWS) * DM;
#pragma unroll
            for (int j = 0; j < 4; ++j) { const f32x4 v = *((const f32x4*)src + lane + 64 * j); u32x2 w; w.x = cvtpk(v[0], v[1]); w.y = cvtpk(v[2], v[3]); *((u32x2*)dst + lane + 64 * j) = w; }
        }
        {
            const int gt = bx * (NWAVES * 64) + tid, NT = G * NWAVES * 64;
            for (int i = gt; i < 8 * 512 * 128; i += NT) { const int b = i / (512 * 128), rem = i % (512 * 128);
                const f32x4 a = *((const f32x4*)args.in[3] + i), v = *((const f32x4*)args.in[4] + i); u32x2 w;
                w.x = cvtpk(a[0], a[1]); w.y = cvtpk(a[2], a[3]); *(u32x2*)(KAS + (size_t)b * 544 * 512 + (size_t)rem * 4) = w;
                w.x = cvtpk(v[0], v[1]); w.y = cvtpk(v[2], v[3]); *(u32x2*)(VAS + (size_t)b * 544 * 512 + (size_t)rem * 4) = w; }
            for (int i = gt; i < 8 * 1024 * 128; i += NT) { const int b = i / (1024 * 128), rem = i % (1024 * 128);
                const f32x4 a = *((const f32x4*)args.in[5] + i), v = *((const f32x4*)args.in[6] + i); u32x2 w;
                w.x = cvtpk(a[0], a[1]); w.y = cvtpk(a[2], a[3]); *(u32x2*)(KBS + (size_t)b * 1056 * 512 + (size_t)rem * 4) = w;
                w.x = cvtpk(v[0], v[1]); w.y = cvtpk(v[2], v[3]); *(u32x2*)(VBS + (size_t)b * 1056 * 512 + (size_t)rem * 4) = w; }
            for (int i = gt; i < 8 * 256 * 256; i += NT) {
                const f32x4 a = *((const f32x4*)args.in[7] + i), v = *((const f32x4*)args.in[8] + i); u32x2 w;
                w.x = cvtpk(a[0], a[1]); w.y = cvtpk(a[2], a[3]); *(u32x2*)(MKS + (size_t)i * 4) = w;
                w.x = cvtpk(v[0], v[1]); w.y = cvtpk(v[2], v[3]); *(u32x2*)(MVS + (size_t)i * 4) = w; }
            for (int i = gt; i < SEQ * 8; i += NT) { const int pos = i >> 3, j = i & 7;
                const double inv = (j == 0) ? 1.0 : (j == 1) ? 0.19392274474868576 : (j == 2) ? 0.03760603093086393 : (j == 3) ? 0.007292664737217109 : (j == 4) ? 0.001414213562373095 :
                                   (j == 5) ? 0.0002742481756762073 : (j == 6) ? 5.318295896944988e-05 : 1.031338537721246e-05;
                double s, c; sincos_d((double)pos * inv, s, c); ROPE[(size_t)pos * 16 + j] = (float)c; ROPE[(size_t)pos * 16 + 8 + j] = (float)s; }
            for (int i = gt; i < 8 * 640; i += NT) { const int h = i / 640, rel = (i % 640) - 63; const int cl = rel < -128 ? -128 : (rel > 128 ? 128 : rel);
                BT[i] = args.in[11][h * 257 + cl + 128] * LOG2E; }
            if (gt == 0) { float s1 = 0.f, s2 = 0.f; for (int d = 0; d < 64; ++d) { s1 += args.in[12][d] * args.in[13][d]; s2 += args.in[14][d] * args.in[15][d]; }
                LAMP[0] = expf(s1) - expf(s2) + 0.2f; }
        }
    }
    SEAM(0);
    if (IN(1)) {
        { pg8::Gemm g{XB, Wqkv_t, DM, DM, DM}; pg8::StaticOrder S; S.init(65, 12, G, bx);
          pg8::EpiQKV E{QKVB, out, ROPE, KAS, VAS, KBS, VBS};
          pg8::gemm_phase<pg8::EpiQKV, 0, true, true>(lds, g, S, E); }
        { pg8::Gemm g{MEMB, Wmkv_t, DM, DM, DM}; pg8::StaticOrder S; S.init(1, 8, G, (bx + G - 12) % G);
          pg8::EpiMemKV E{out, MKB, MVB};
          pg8::gemm_phase<pg8::EpiMemKV, 0, true, true>(lds, g, S, E); }
    }
    SEAM(1);
    if (IN(2)) {
        LAS unsigned char* wl = lds + wave * 8192;
        {
            const int vcu = (G % 8 == 0) ? (bx % 8) * (G / 8) + bx / 8 : bx;
            for (int i = 0; i * G < 1024; ++i) {
                int hmv, qb;
                if (G == 256) { const int s = vcu & 15; hmv = vcu >> 4; qb = (i == 0) ? s : (i == 1) ? 31 - s : (i == 2) ? 32 + s : 63 - s; }
                else { const int u = i * G + vcu; if (u >= 1024) break; hmv = u & 15; qb = 63 - (u >> 4); }
                const int hm = hmv >> 1, vh = hmv & 1;
                attn_body::attn_unit<8>(qb, (const bf16_t*)(ws + WS_QKVB) + 1536 + hm * 64, (const bf16_t*)(ws + WS_QKVB) + 2048 + hm * 64, (const bf16_t*)(ws + WS_QKVB) + 2560 + (hm >> 1) * 128 + vh * 64, NQKV,
                                        (bf16_t*)(ws + WS_OD) + hm * 128 + vh * 64, DM, (char*)lds_raw);
            }
            __syncthreads();
        }
        for (int u = gw; u < 4096; u += NGW) {
            const int qblk = u >> 3, h = u & 7, c = qblk >> 1, klo = (64 * c - 512) < 0 ? 0 : (64 * c - 512), nk = 64 * c + 64 - klo;
            gsa_wave<64, true>(QKVB + (size_t)(qblk * 32) * NQKV + h * 64, NQKV, QKVB + (size_t)klo * NQKV + 512 + h * 64, NQKV, QKVB + (size_t)klo * NQKV + 1024 + h * 64, NQKV, nk,
                               BT + h * 640, qblk * 32 - klo + 63, MIXA + (size_t)(qblk * 32) * DM + h * 64, DM, wl, lane);
        }
        for (int u = gw; u < 192; u += NGW) {
            if (u < 64) { const int b = u >> 3, h = u & 7;
                gsa_wave<64, true>(QKVB + (size_t)(SEQ + b * 32) * NQKV + h * 64, NQKV, KAS + (size_t)b * 544 * 512 + h * 64, 512, VAS + (size_t)b * 544 * 512 + h * 64, 512, 544,
                                   BT + h * 640, 512 + 63, MIXA + (size_t)(SEQ + b * 32) * DM + h * 64, DM, wl, lane);
            } else { const int v = u - 64, b = v >> 4, hmv = v & 15, hm = hmv >> 1, vh = hmv & 1;
                gsa_wave<64, false>(QKVB + (size_t)(SEQ + b * 32) * NQKV + 1536 + hm * 64, NQKV, KBS + (size_t)b * 1056 * 512 + hm * 64, 512, VBS + (size_t)b * 1056 * 512 + (hm >> 1) * 128 + vh * 64, 512, 1056,
                                    nullptr, 0, OD + (size_t)(SEQ + b * 32) * DM + hm * 128 + vh * 64, DM, wl, lane);
            }
        }
    }
    SEAM(2);
    if (IN(3)) {
        const float lam = LAMP[0];
        const int h = lane >> 4, d0 = (lane & 15) * 8;
        f32x4 g0 = *(const f32x4*)(args.in[16] + d0), g1 = *(const f32x4*)(args.in[16] + d0 + 4);
        for (int m = gw; m < MROWS; m += NGW) {
            const u32x4 a = *(const u32x4*)(OD + (size_t)m * DM + h * 256 + d0), b = *(const u32x4*)(OD + (size_t)m * DM + h * 256 + 128 + d0);
            float o[8]; float ss = 0.f;
#pragma unroll
            for (int j = 0; j < 4; ++j) { const unsigned ua = a[j], ub = b[j];
                o[2 * j] = __uint_as_float(ua << 16) - lam * __uint_as_float(ub << 16); o[2 * j + 1] = __uint_as_float(ua & 0xffff0000u) - lam * __uint_as_float(ub & 0xffff0000u);
                ss += o[2 * j] * o[2 * j] + o[2 * j + 1] * o[2 * j + 1]; }
            ss += __shfl_xor(ss, 1); ss += __shfl_xor(ss, 2); ss += __shfl_xor(ss, 4); ss += __shfl_xor(ss, 8);
            const float rn = 0.8f / sqrtf(ss * (1.f / 128.f) + LN_EPS);
            u32x4 w; w.x = cvtpk(o[0] * rn * g0[0], o[1] * rn * g0[1]); w.y = cvtpk(o[2] * rn * g0[2], o[3] * rn * g0[3]); w.z = cvtpk(o[4] * rn * g1[0], o[5] * rn * g1[1]); w.w = cvtpk(o[6] * rn * g1[2], o[7] * rn * g1[3]);
            *(u32x4*)(MIXA + (size_t)m * DM + 512 + h * 128 + d0) = w;
        }
    }
    SEAM(3);
    if (IN(4)) {
        pg8::Gemm g{MIXA, Wo_t, DM, DM, DM}; pg8::StaticOrder S; S.init(65, 4, G, bx);
        pg8::EpiResid E{x_prompt, x_sample, R};
        pg8::gemm_phase<pg8::EpiResid, 0, true, true>(lds, g, S, E);
    }
    SEAM(4);
#define LN_PASS(gp, bp, XO) do { \
        for (int m = gw; m < MROWS; m += NGW) { \
            f32x4* xr = (f32x4*)(R + (size_t)m * DM) + lane; f32x4 v[4]; float s = 0.f; \
            _Pragma("unroll") for (int j = 0; j < 4; ++j) { v[j] = xr[64 * j]; s += (v[j][0] + v[j][1]) + (v[j][2] + v[j][3]); } \
            const float mean = wave_sum(s) * (1.f / DM); float s2 = 0.f; \
            _Pragma("unroll") for (int j = 0; j < 4; ++j) { v[j] = v[j] - mean; s2 += (v[j][0] * v[j][0] + v[j][1] * v[j][1]) + (v[j][2] * v[j][2] + v[j][3] * v[j][3]); } \
            const float rstd = 1.f / sqrtf(wave_sum(s2) * (1.f / DM) + LN_EPS); \
            _Pragma("unroll") for (int j = 0; j < 4; ++j) { const f32x4 gg = *((const f32x4*)(gp) + lane + 64 * j), bb = *((const f32x4*)(bp) + lane + 64 * j); \
                const f32x4 y = v[j] * rstd * gg + bb; xr[64 * j] = y; \
                if (XO) { u32x2 w; w.x = cvtpk(y[0], y[1]); w.y = cvtpk(y[2], y[3]); *((u32x2*)((bf16_t*)(XO) + (size_t)m * DM) + lane + 64 * j) = w; } } \
        } } while (0)
    if (IN(5)) { LN_PASS(args.in[18], args.in[19], X1B); }
    SEAM(5);
    if (IN(6)) {
        pg8::Gemm g{X1B, Wmq_t, DM, DM, DM}; pg8::StaticOrder S; S.init(65, 4, G, bx);
        pg8::EpiBf16S E{QM, DM, C2M};
        pg8::gemm_phase<pg8::EpiBf16S, 0, true, true>(lds, g, S, E);
    }
    SEAM(6);
    if (IN(7)) {
        LAS unsigned char* wl = lds + wave * 8192;
        for (int u = gw; u < 520 * 16; u += NGW) {
            const int qblk = u >> 4, h = (u >> 2) & 3, vc = u & 3;
            const bf16_t* kk = (qblk < 512) ? MKB : MKS + (size_t)(qblk - 512) * 256 * 1024; const bf16_t* vv = (qblk < 512) ? MVB : MVS + (size_t)(qblk - 512) * 256 * 1024;
            gsa_wave<256, false>(QM + (size_t)(qblk * 32) * DM + h * 256, DM, kk + h * 256, DM, vv + h * 256 + vc * 64, DM, 256, nullptr, 0, OM + (size_t)(qblk * 32) * DM + h * 256 + vc * 64, DM, wl, lane);
        }
    }
    SEAM(7);
    if (IN(8)) {
        pg8::Gemm g{OM, Wmo_t, DM, DM, DM}; pg8::StaticOrder S; S.init(65, 4, G, bx);
        pg8::EpiResid E{R, R + (size_t)SEQ * DM, R};
        pg8::gemm_phase<pg8::EpiResid, 0, true, true>(lds, g, S, E);
    }
    SEAM(8);
    if (IN(9)) {
        if (bx == 0) { for (int i = tid; i < 1024; i += NWAVES * 64) ((unsigned*)(ws + WS_X2B - 4096))[i] = 0u; }
        LN_PASS(args.in[24], args.in[25], X2B);
    }
    SEAM(9);
    if (IN(10)) {
        { pg8::Gemm g{X2B, Wup_t, DM, DM, DM}; pg8::StaticOrder S; S.init(67, 22, G, bx);
          pg8::EpiUpConv<false> E{HB, args.in[27], args.in[28], args.in[9], out + OFF_CVP, out + OFF_CVS};
          pg8::gemm_phase<pg8::EpiUpConv<false>, 1, true, true>(lds, g, S, E); }
        { pg8::Gemm g{X2B + (size_t)SEQ * DM, Wup_t, DM, DM, DM}; pg8::StaticOrder S; S.init(1, 22, G, (bx + G - 194) % G);
          pg8::EpiUpConv<true> E{HB, args.in[27], args.in[28], args.in[9], out + OFF_CVP, out + OFF_CVS};
          pg8::gemm_phase<pg8::EpiUpConv<true>, 0, true, true>(lds, g, S, E); }
    }
    SEAM(10);
    if (IN(11)) {
        pg8::Gemm g{HB, Wdn_t, DFF, DFF, DFF}; pg8::StaticOrder S; S.init(65, 4, G, bx);
        pg8::EpiResid E{R, R + (size_t)SEQ * DM, R};
        pg8::gemm_phase<pg8::EpiResid, 0, true, true>(lds, g, S, E);
    }
    SEAM(11);
    if (IN(12)) { LN_PASS(args.in[30], args.in[31], (bf16_t*)nullptr); }
#undef IN
#undef SEAM
}

extern "C" void kernel_launch(void* const* d_in, const int* in_sizes, int n_in, void* d_out, int out_size, void* d_ws, size_t ws_size, hipStream_t stream) {
    static int grid = 0;
    if (grid == 0) {
        int dev = 0, cus = 0;
        if (hipGetDevice(&dev) != hipSuccess || hipDeviceGetAttribute(&cus, hipDeviceAttributeMultiprocessorCount, dev) != hipSuccess) { fprintf(stderr, "kernel_launch: device query failed\n"); grid = -1; return; }
        if (hipFuncSetAttribute((const void*)mk_fwd, hipFuncAttributeMaxDynamicSharedMemorySize, LDS_BYTES) != hipSuccess) { fprintf(stderr, "kernel_launch: hipFuncSetAttribute failed\n"); grid = -1; return; }
        int per_cu = 0;
        if (hipOccupancyMaxActiveBlocksPerMultiprocessor(&per_cu, (const void*)mk_fwd, NWAVES * 64, LDS_BYTES) != hipSuccess || per_cu < 1) fprintf(stderr, "kernel_launch: occupancy query reports %d\n", per_cu);
        (void)hipGetLastError();
        grid = cus;
        fprintf(stderr, "kernel_launch: grid %d, ws %zu, n_in %d, out %d\n", grid, ws_size, n_in, out_size);
    }
    if (grid < 0) return;
    (void)hipMemsetAsync((char*)d_ws + WS_CTL, 0, CTL_ZERO_BYTES, stream);
    Args a{};
    for (int i = 0; i < 32; ++i) a.in[i] = (const float*)d_in[i];
    a.out = (float*)d_out; a.ws = (unsigned char*)d_ws;
    if (N_LAUNCHES == 1) { a.ph_lo = 0; a.ph_hi = NPHASE; a.li = 0; hipLaunchKernelGGL(mk_fwd, dim3(grid), dim3(NWAVES * 64), LDS_BYTES, stream, a); }
    else for (int li = 0; li < NPHASE; ++li) { a.ph_lo = li; a.ph_hi = li + 1; a.li = li; hipLaunchKernelGGL(mk_fwd, dim3(grid), dim3(NWAVES * 64), LDS_BYTES, stream, a); }
}
```

```cpp
#include <hip/hip_runtime.h>
#include <cstdio>
#include <cstdint>

#define LAS __attribute__((address_space(3)))
#define GAS __attribute__((address_space(1)))
typedef unsigned short bf16_t;
typedef short bf16x8 __attribute__((ext_vector_type(8)));
typedef short s16x4 __attribute__((ext_vector_type(4)));
typedef float f32x2 __attribute__((ext_vector_type(2)));
typedef float f32x4 __attribute__((ext_vector_type(4)));
typedef float f32x16 __attribute__((ext_vector_type(16)));
typedef unsigned u32x2 __attribute__((ext_vector_type(2)));
typedef unsigned u32x4 __attribute__((ext_vector_type(4)));
typedef __bf16 bf16x2_t __attribute__((ext_vector_type(2)));

constexpr int DM = 1024, SEQ = 16384, NSAMP = 256, MROWS = SEQ + NSAMP;
constexpr int NQKV = 3072, DFF = 2816, DFF2 = 5632;
constexpr float LN_EPS = 1e-5f;
constexpr float ALPHA = 1.189207115002721f;
constexpr float LOG2E = 1.4426950408889634f;
constexpr float C2 = 0.125f * LOG2E;
constexpr float C2M = 0.0625f * LOG2E;
constexpr size_t OFF_Y = 0, OFF_AKP = 17039360, OFF_AVP = 17301504, OFF_BKP = 17563648, OFF_BVP = 25952256, OFF_MKP = 34340864, OFF_MVP = 34603008,
                 OFF_CVP = 34865152, OFF_AKS = 34876416, OFF_AVS = 35007488, OFF_BKS = 35138560, OFF_BVS = 35269632, OFF_CVS = 35400704;
constexpr size_t MiB = 1u << 20;
constexpr size_t WS_CTL = 0, CTL_ZERO_BYTES = 1 * MiB;
constexpr size_t WS_ROPE = 1 * MiB, WS_BT = 2 * MiB, WS_LAM = 2 * MiB + 32768;
constexpr size_t WS_WQKV = 3 * MiB, WS_WO = 9 * MiB, WS_WMQ = 11 * MiB, WS_WMKV = 13 * MiB, WS_WMO = 17 * MiB, WS_WUP = 19 * MiB, WS_WDN = 30 * MiB;
constexpr size_t WS_MEMB = 36 * MiB, WS_MKB = 36 * MiB + 512 * 1024, WS_MVB = 37 * MiB;
constexpr size_t WS_KAS = 38 * MiB, WS_VAS = 42 * MiB + 512 * 1024, WS_KBS = 47 * MiB, WS_VBS = 55 * MiB + 512 * 1024, WS_MKS = 64 * MiB, WS_MVS = 68 * MiB;
constexpr size_t WS_QKVB = 72 * MiB, WS_XB = 170 * MiB, WS_OD = 170 * MiB, WS_MIXA = 203 * MiB, WS_X1B = 203 * MiB, WS_X2B = 203 * MiB + 4096;
constexpr size_t WS_QM = 72 * MiB, WS_OM = 105 * MiB, WS_H = 72 * MiB;
constexpr size_t WS_SQKV = 236 * MiB, WS_SMIXA = 238 * MiB, WS_SOD = 238 * MiB + 512 * 1024, WS_SX1B = 239 * MiB, WS_SX2B = 239 * MiB + 512 * 1024, WS_SQM = 240 * MiB, WS_SOM = 240 * MiB + 512 * 1024, WS_SH = 241 * MiB;
constexpr int CW_TEAM = 8192;
constexpr int TEAM_S = 24, TEAM_J0 = 29;

__device__ __forceinline__ unsigned cvtpk(float lo, float hi) { f32x2 v = {lo, hi}; bf16x2_t b = __builtin_convertvector(v, bf16x2_t); return __builtin_bit_cast(unsigned, b); }
__device__ __forceinline__ bf16_t f2bf(float f) { return (bf16_t)(cvtpk(f, 0.f) & 0xffffu); }

namespace pg8 {
constexpr int BM = 256, BK = 64, HALF = 128, HTB = HALF * BK * 2, STAGE_BYTES = 8 * HTB, NXCD = 8, WGM = 8;
__host__ __device__ __forceinline__ int lds_byte(int r, int c) { const int st = (r >> 4) * 2 + (c >> 5), rr = r & 15, cc = c & 31, ob = rr * 64 + cc * 2; return st * 1024 + (ob ^ (((ob >> 9) & 1) << 5)); }
__host__ __device__ __forceinline__ void stage_rc(int b, int& R, int& C) { const int st = b / 1024, sb = b % 1024, swz = sb ^ (((sb >> 9) & 1) << 5); R = (st >> 1) * 16 + swz / 64; C = (st & 1) * 32 + (swz % 64) / 2; }
__host__ __device__ __forceinline__ int perm32(int rho) { const int n = rho >> 4, i = rho & 15; return 8 * (i >> 2) + 4 * n + (i & 3); }
struct Unit { int pm, pn; };
struct Gemm { const bf16_t* A; const bf16_t* Bt; int lda, ldb, K; };
struct StaticOrder {
    int nM, nN, nwg, G, c, pm0;
    __host__ __device__ void init(int nM_, int nN_, int G_, int c_, int pm0_ = 0) { nM = nM_; nN = nN_; nwg = nM * nN; G = G_; c = c_; pm0 = pm0_; }
    __host__ __device__ bool next(int i, Unit& u) const {
        const long L = (long)i * G + c; if (L >= nwg) return false;
        int wgid = (int)L; { const int q = nwg / NXCD, r = nwg % NXCD, xcd = wgid % NXCD, off = wgid / NXCD; wgid = (xcd < r ? xcd * (q + 1) : r * (q + 1) + (xcd - r) * q) + off; }
        const int nig = WGM * nN, gid = wgid / nig, fm = gid * WGM, gsz = (nM - fm) < WGM ? (nM - fm) : WGM;
        u.pm = pm0 + fm + ((wgid % nig) % gsz); u.pn = (wgid % nig) / gsz; return true;
    }
};
template <class Epi, int AMODE, bool ALIGN_EPI, bool SP2>
__device__ __forceinline__ void gemm_phase(LAS unsigned char* lds, const Gemm g, const StaticOrder& S, const Epi& E) {
    const int tid = threadIdx.x, wid = __builtin_amdgcn_readfirstlane(tid >> 6), lane = tid & 63, wr = wid >> 2, wc = wid & 3, fr = lane & 15, fq = lane >> 4;
    const int K = g.K, nt = K / BK;
    unsigned voffA[2], voffB[2];
#pragma unroll
    for (int i = 0; i < 2; ++i) { int R, C; stage_rc(tid * 16 + i * 8192, R, C); const int Rb = Epi::PERM ? ((R & ~31) + perm32(R & 31)) : R;
        const int Ra = (AMODE == 1) ? (62 * (R >> 6) + (R & 63)) : R;
        voffA[i] = (unsigned)(Ra * g.lda + C) * 2u; voffB[i] = (unsigned)(Rb * g.ldb + C) * 2u; }
    const size_t kstep = (size_t)(BK * 2);
    const size_t hstepA = (size_t)((AMODE == 1) ? 124 : 128) * g.lda * 2, hstepB = (size_t)HALF * g.ldb * 2;
    const unsigned ldsw = (unsigned)wid * 1024u;
    const int aoff = lds_byte(wr * 64 + fr, fq * 8), boff = lds_byte(wc * 32 + fr, fq * 8);
#define PG8_TILEA(pm) ((const char*)g.A + (ptrdiff_t)((AMODE == 1) ? (248 * (pm) - 2) : (256 * (pm))) * g.lda * 2)
#define PG8_TILEB(pn) ((const char*)g.Bt + (size_t)(256 * (pn)) * g.ldb * 2)
#define PG8_SA(b, h) (((b) * 2 + (h)) * HTB)
#define PG8_SB(b, h) ((4 + (b) * 2 + (h)) * HTB)
#define PG8_STAGE(bufoff, gbase, voff) do { _Pragma("unroll") for (int _i = 0; _i < 2; ++_i) \
        __builtin_amdgcn_global_load_lds((const unsigned*)((const char*)(gbase) + (voff)[_i]), (LAS unsigned*)(lds + (bufoff) + ldsw + _i * 8192), 16, 0, 0); } while (0)
#define PG8_LDA(dst, b, h) do { _Pragma("unroll") for (int m = 0; m < 4; ++m) _Pragma("unroll") for (int k = 0; k < 2; ++k) dst[m][k] = *(const LAS bf16x8*)(lds + PG8_SA(b, h) + aoff + m * 2048 + k * 1024); } while (0)
#define PG8_LDB(dst, b, h) do { _Pragma("unroll") for (int n = 0; n < 2; ++n) _Pragma("unroll") for (int k = 0; k < 2; ++k) dst[n][k] = *(const LAS bf16x8*)(lds + PG8_SB(b, h) + boff + n * 2048 + k * 1024); } while (0)
#define PG8_MMA(ai, bj, At, Bt) do { __builtin_amdgcn_s_setprio(1); _Pragma("unroll") for (int m = 0; m < 4; ++m) _Pragma("unroll") for (int n = 0; n < 2; ++n) _Pragma("unroll") for (int k = 0; k < 2; ++k) \
        acc[ai][bj][m][n] = __builtin_amdgcn_mfma_f32_16x16x32_bf16(Bt[n][k], At[m][k], acc[ai][bj][m][n], 0, 0, 0); __builtin_amdgcn_s_setprio(0); } while (0)
#define PG8_WAIT_V(n) asm volatile("s_waitcnt vmcnt(" #n ")" ::: "memory")
#define PG8_WAIT_L(n) asm volatile("s_waitcnt lgkmcnt(" #n ")" ::: "memory")
#define PG8_BAR __builtin_amdgcn_s_barrier()
#define PG8_SCHED __builtin_amdgcn_sched_barrier(0)
    Unit cur, nxt; int ui = 0;
    if (!S.next(0, cur)) return;
    f32x4 acc[2][2][4][2];
#pragma unroll
    for (int a = 0; a < 2; ++a)
#pragma unroll
        for (int b = 0; b < 2; ++b)
#pragma unroll
            for (int m = 0; m < 4; ++m)
#pragma unroll
                for (int n = 0; n < 2; ++n) acc[a][b][m][n] = (f32x4){0.f, 0.f, 0.f, 0.f};
    bf16x8 At[4][2], B0[2][2], B1[2][2];
    const char* cA = PG8_TILEA(cur.pm); const char* cB = PG8_TILEB(cur.pn);
    if constexpr (SP2) {
        PG8_STAGE(PG8_SB(0, 0), cB, voffB); PG8_STAGE(PG8_SB(0, 1), cB + hstepB, voffB); PG8_STAGE(PG8_SA(0, 0), cA, voffA); PG8_STAGE(PG8_SA(0, 1), cA + hstepA, voffA);
        if (wr == 1) PG8_BAR;
        PG8_WAIT_V(2); PG8_BAR;
        PG8_STAGE(PG8_SB(1, 0), cB + kstep, voffB); PG8_STAGE(PG8_SA(1, 0), cA + kstep, voffA); PG8_STAGE(PG8_SB(1, 1), cB + hstepB + kstep, voffB);
        PG8_WAIT_V(6); PG8_BAR;
    } else {
        PG8_STAGE(PG8_SB(0, 0), cB, voffB); PG8_STAGE(PG8_SA(0, 0), cA, voffA); PG8_STAGE(PG8_SB(0, 1), cB + hstepB, voffB); PG8_STAGE(PG8_SA(0, 1), cA + hstepA, voffA);
        if (wr == 1) PG8_BAR;
        PG8_WAIT_V(4); PG8_BAR;
        PG8_STAGE(PG8_SB(1, 0), cB + kstep, voffB); PG8_STAGE(PG8_SA(1, 0), cA + kstep, voffA); PG8_STAGE(PG8_SB(1, 1), cB + hstepB + kstep, voffB);
        PG8_WAIT_V(6); PG8_BAR;
    }
    for (;;) {
        const bool has_next = S.next(ui + 1, nxt);
        const char* nA = has_next ? PG8_TILEA(nxt.pm) : cA; const char* nB = has_next ? PG8_TILEB(nxt.pn) : cB;
        for (int t = 0; t < nt; t += 2) {
            const bool last = (t == nt - 2);
            const char* a1 = cA + (size_t)(t + 1) * kstep;
            const char* a2 = last ? nA : cA + (size_t)(t + 2) * kstep; const char* b2 = last ? nB : cB + (size_t)(t + 2) * kstep;
            const char* a3 = a2 + kstep; const char* b3 = b2 + kstep;
            if constexpr (SP2) {
            PG8_LDB(B0, 0, 0); PG8_LDB(B1, 0, 1); PG8_SCHED; PG8_LDA(At, 0, 0); PG8_STAGE(PG8_SA(1, 1), a1 + hstepA, voffA);
            PG8_WAIT_V(8); PG8_WAIT_L(0); PG8_BAR; PG8_MMA(0, 0, At, B0); PG8_MMA(0, 1, At, B1); PG8_BAR; PG8_SCHED;
            PG8_LDA(At, 0, 1); PG8_STAGE(PG8_SB(0, 0), b2, voffB); PG8_STAGE(PG8_SB(0, 1), b2 + hstepB, voffB); PG8_STAGE(PG8_SA(0, 0), a2, voffA);
            PG8_WAIT_V(8); PG8_WAIT_L(0); PG8_BAR; PG8_MMA(1, 0, At, B0); PG8_MMA(1, 1, At, B1); PG8_BAR; PG8_SCHED;
            PG8_LDB(B0, 1, 0); PG8_LDB(B1, 1, 1); PG8_SCHED; PG8_LDA(At, 1, 0); PG8_STAGE(PG8_SA(0, 1), a2 + hstepA, voffA);
            PG8_WAIT_V(8); PG8_WAIT_L(0); PG8_BAR; PG8_MMA(0, 0, At, B0); PG8_MMA(0, 1, At, B1); PG8_BAR; PG8_SCHED;
            PG8_LDA(At, 1, 1); PG8_STAGE(PG8_SB(1, 0), b3, voffB); PG8_STAGE(PG8_SB(1, 1), b3 + hstepB, voffB); PG8_STAGE(PG8_SA(1, 0), a3, voffA);
            PG8_WAIT_V(8); PG8_WAIT_L(0); PG8_BAR; PG8_MMA(1, 0, At, B0); PG8_MMA(1, 1, At, B1); PG8_BAR; PG8_SCHED;
            } else {
            PG8_LDB(B0, 0, 0); PG8_SCHED; PG8_LDA(At, 0, 0); PG8_STAGE(PG8_SA(1, 1), a1 + hstepA, voffA);
            PG8_WAIT_L(8); PG8_BAR; PG8_WAIT_L(0); PG8_MMA(0, 0, At, B0); PG8_BAR; PG8_SCHED;
            PG8_LDB(B1, 0, 1); PG8_STAGE(PG8_SB(0, 0), b2, voffB);
            PG8_BAR; PG8_WAIT_L(0); PG8_MMA(0, 1, At, B1); PG8_BAR;
            PG8_LDA(At, 0, 1); PG8_STAGE(PG8_SA(0, 0), a2, voffA);
            PG8_BAR; PG8_WAIT_L(0); PG8_MMA(1, 0, At, B0); PG8_BAR; PG8_SCHED;
            PG8_STAGE(PG8_SB(0, 1), b2 + hstepB, voffB);
            PG8_WAIT_V(6); PG8_BAR; PG8_MMA(1, 1, At, B1); PG8_BAR;
            PG8_LDB(B0, 1, 0); PG8_SCHED; PG8_LDA(At, 1, 0); PG8_STAGE(PG8_SA(0, 1), a2 + hstepA, voffA);
            PG8_WAIT_L(8); PG8_BAR; PG8_WAIT_L(0); PG8_MMA(0, 0, At, B0); PG8_BAR; PG8_SCHED;
            PG8_LDB(B1, 1, 1); PG8_STAGE(PG8_SB(1, 0), b3, voffB);
            PG8_BAR; PG8_WAIT_L(0); PG8_MMA(0, 1, At, B1); PG8_BAR;
            PG8_LDA(At, 1, 1); PG8_STAGE(PG8_SA(1, 0), a3, voffA);
            PG8_BAR; PG8_WAIT_L(0); PG8_MMA(1, 0, At, B0); PG8_BAR; PG8_SCHED;
            PG8_STAGE(PG8_SB(1, 1), b3 + hstepB, voffB);
            PG8_WAIT_V(6); PG8_BAR; PG8_MMA(1, 1, At, B1); PG8_BAR;
            }
        }
        if constexpr (ALIGN_EPI) { if (wr == 0) PG8_BAR; }
        E(acc, cur, wr, wc, fr, fq);
        if (!has_next) break;
#pragma unroll
        for (int a = 0; a < 2; ++a)
#pragma unroll
            for (int b = 0; b < 2; ++b)
#pragma unroll
                for (int m = 0; m < 4; ++m)
#pragma unroll
                    for (int n = 0; n < 2; ++n) acc[a][b][m][n] = (f32x4){0.f, 0.f, 0.f, 0.f};
        cur = nxt; cA = nA; cB = nB; ++ui;
        if constexpr (ALIGN_EPI) { if (wr == 1) PG8_BAR; }
    }
    PG8_WAIT_V(0);
    if constexpr (!ALIGN_EPI) { if (wr == 0) PG8_BAR; }
    PG8_BAR;
#undef PG8_TILEA
#undef PG8_TILEB
#undef PG8_SA
#undef PG8_SB
#undef PG8_STAGE
#undef PG8_LDA
#undef PG8_LDB
#undef PG8_MMA
#undef PG8_WAIT_V
#undef PG8_WAIT_L
#undef PG8_BAR
#undef PG8_SCHED
}

struct EpiQKV {
    static constexpr bool PERM = true;
    bf16_t* qkvb; float* out; const float* rope; bf16_t *kas, *vas, *kbs, *vbs;
    __device__ __forceinline__ void operator()(const f32x4 (&acc)[2][2][4][2], const Unit& u, int wr, int wc, int fr, int fq) const {
        const int pn = u.pn, pm = u.pm, region = pn >> 1;
        const bool isq = (region == 0) || (region == 3);
        const float sc = isq ? C2 : 1.f;
        const bool rope_on = (pn >= 6 && pn < 10) && ((wc & 1) == 0);
#pragma unroll
        for (int ai = 0; ai < 2; ++ai)
#pragma unroll
            for (int m = 0; m < 4; ++m) {
                const int lr = ai * 128 + wr * 64 + m * 16 + fr, grow = pm * 256 + lr;
                f32x4 cs0 = {1.f, 1.f, 1.f, 1.f}, cs1 = cs0, sn0 = {0.f, 0.f, 0.f, 0.f}, sn1 = sn0;
                if (rope_on) { const int pos = (grow < SEQ) ? grow : 1024 + ((grow - SEQ) & 31); const f32x4* rp = (const f32x4*)(rope + (size_t)pos * 16);
                    cs0 = rp[0]; cs1 = rp[1]; sn0 = rp[2]; sn1 = rp[3]; }
#pragma unroll
                for (int bj = 0; bj < 2; ++bj) {
                    f32x4 v0 = acc[ai][bj][m][0], v1 = acc[ai][bj][m][1];
                    const int c8 = pn * 256 + bj * 128 + wc * 32 + fq * 8, cr = c8 - region * 512;
                    if (rope_on) {
                        f32x4 p0, p1;
#pragma unroll
                        for (int j = 0; j < 4; ++j) { p0[j] = __shfl_xor(v0[j], 16); p1[j] = __shfl_xor(v1[j], 16); }
                        if (fq == 0) { v0 = v0 * cs0 - p0 * sn0; v1 = v1 * cs1 - p1 * sn1; }
                        else if (fq == 1) { v0 = v0 * cs0 + p0 * sn0; v1 = v1 * cs1 + p1 * sn1; }
                    }
                    float* fo = nullptr;
                    if (region == 1 || region == 2) {
                        if (pm == 64) fo = out + (region == 1 ? OFF_AKS : OFF_AVS) + (size_t)(grow - SEQ) * 512 + cr;
                        else if (grow >= SEQ - 512) fo = out + (region == 1 ? OFF_AKP : OFF_AVP) + (size_t)(grow - (SEQ - 512)) * 512 + cr;
                    } else if (region == 4 || region == 5) {
                        if (pm == 64) fo = out + (region == 4 ? OFF_BKS : OFF_BVS) + (size_t)(grow - SEQ) * 512 + cr;
                        else fo = out + (region == 4 ? OFF_BKP : OFF_BVP) + (size_t)grow * 512 + cr;
                    }
                    if (fo) { *(f32x4*)fo = v0; *(f32x4*)(fo + 4) = v1; }
                    u32x4 w; w.x = cvtpk(v0[0] * sc, v0[1] * sc); w.y = cvtpk(v0[2] * sc, v0[3] * sc); w.z = cvtpk(v1[0] * sc, v1[1] * sc); w.w = cvtpk(v1[2] * sc, v1[3] * sc);
                    *(u32x4*)(qkvb + (size_t)grow * NQKV + c8) = w;
                    if (pm == 64) { const int b = (grow - SEQ) >> 5, t = (grow - SEQ) & 31;
                        if (region == 1) *(u32x4*)(kas + ((size_t)(b * 544 + 512 + t)) * 512 + cr) = w;
                        else if (region == 2) *(u32x4*)(vas + ((size_t)(b * 544 + 512 + t)) * 512 + cr) = w;
                        else if (region == 4) *(u32x4*)(kbs + ((size_t)(b * 1056 + 1024 + t)) * 512 + cr) = w;
                        else if (region == 5) *(u32x4*)(vbs + ((size_t)(b * 1056 + 1024 + t)) * 512 + cr) = w; }
                }
            }
    }
};
struct EpiMemKV {
    static constexpr bool PERM = true;
    float* out; bf16_t *mkb, *mvb;
    __device__ __forceinline__ void operator()(const f32x4 (&acc)[2][2][4][2], const Unit& u, int wr, int wc, int fr, int fq) const {
        const bool isv = u.pn >= 4;
        float* fb = out + (isv ? OFF_MVP : OFF_MKP); bf16_t* bb = isv ? mvb : mkb;
#pragma unroll
        for (int ai = 0; ai < 2; ++ai)
#pragma unroll
            for (int m = 0; m < 4; ++m) { const int lr = ai * 128 + wr * 64 + m * 16 + fr;
#pragma unroll
                for (int bj = 0; bj < 2; ++bj) { const f32x4 v0 = acc[ai][bj][m][0], v1 = acc[ai][bj][m][1];
                    const int c8 = (u.pn & 3) * 256 + bj * 128 + wc * 32 + fq * 8;
                    *(f32x4*)(fb + (size_t)lr * 1024 + c8) = v0; *(f32x4*)(fb + (size_t)lr * 1024 + c8 + 4) = v1;
                    u32x4 w; w.x = cvtpk(v0[0], v0[1]); w.y = cvtpk(v0[2], v0[3]); w.z = cvtpk(v1[0], v1[1]); w.w = cvtpk(v1[2], v1[3]);
                    *(u32x4*)(bb + (size_t)lr * 1024 + c8) = w; } }
    }
};
struct EpiResid {
    static constexpr bool PERM = false;
    const float* base0; const float* base1; float* out;
    __device__ __forceinline__ void operator()(const f32x4 (&acc)[2][2][4][2], const Unit& u, int wr, int wc, int fr, int fq) const {
#pragma unroll
        for (int ai = 0; ai < 2; ++ai)
#pragma unroll
            for (int m = 0; m < 4; ++m) { const int grow = u.pm * 256 + ai * 128 + wr * 64 + m * 16 + fr;
                const float* bp = (u.pm < 64) ? base0 + (size_t)grow * DM : base1 + (size_t)(grow - SEQ) * DM; float* op = out + (size_t)grow * DM;
#pragma unroll
                for (int bj = 0; bj < 2; ++bj)
#pragma unroll
                    for (int n = 0; n < 2; ++n) { const int col = u.pn * 256 + bj * 128 + wc * 32 + n * 16 + fq * 4;
                        const f32x4 b = *(const f32x4*)(bp + col); *(f32x4*)(op + col) = b * ALPHA + acc[ai][bj][m][n]; } }
    }
};
struct EpiBf16S {
    static constexpr bool PERM = true;
    bf16_t* O; int ldc; float scale;
    __device__ __forceinline__ void operator()(const f32x4 (&acc)[2][2][4][2], const Unit& u, int wr, int wc, int fr, int fq) const {
#pragma unroll
        for (int ai = 0; ai < 2; ++ai)
#pragma unroll
            for (int m = 0; m < 4; ++m) { const int grow = u.pm * 256 + ai * 128 + wr * 64 + m * 16 + fr;
#pragma unroll
                for (int bj = 0; bj < 2; ++bj) { const f32x4 v0 = acc[ai][bj][m][0] * scale, v1 = acc[ai][bj][m][1] * scale;
                    const int c8 = u.pn * 256 + bj * 128 + wc * 32 + fq * 8;
                    u32x4 w; w.x = cvtpk(v0[0], v0[1]); w.y = cvtpk(v0[2], v0[3]); w.z = cvtpk(v1[0], v1[1]); w.w = cvtpk(v1[2], v1[3]);
                    *(u32x4*)(O + (size_t)grow * ldc + c8) = w; } }
    }
};
template <bool SAMPLE> struct EpiUpConv {
    static constexpr bool PERM = true;
    bf16_t* H; const float* cw; const float* cb; const float* state; float* convp; float* convs;
    __device__ __forceinline__ void operator()(const f32x4 (&acc)[2][2][4][2], const Unit& u, int wr, int wc, int fr, int fq) const {
        const int lane = threadIdx.x & 63;
        const int src1 = (lane & 48) | ((lane - 1) & 15), src2 = (lane & 48) | ((lane - 2) & 15);
#pragma unroll
        for (int n = 0; n < 2; ++n) {
            const int gcol = u.pn * 128 + wc * 32 + fq * 8 + 4 * n;
            const f32x4 w0g = *(const f32x4*)(cw + gcol), w1g = *(const f32x4*)(cw + DFF2 + gcol), w2g = *(const f32x4*)(cw + 2 * DFF2 + gcol), bg = *(const f32x4*)(cb + gcol);
            const f32x4 w0v = *(const f32x4*)(cw + DFF + gcol), w1v = *(const f32x4*)(cw + DFF2 + DFF + gcol), w2v = *(const f32x4*)(cw + 2 * DFF2 + DFF + gcol), bv = *(const f32x4*)(cb + DFF + gcol);
#pragma unroll
            for (int ai = 0; ai < 2; ++ai)
#pragma unroll
                for (int m = 0; m < 4; ++m) {
                    const int lr = ai * 128 + wr * 64 + m * 16 + fr, rho = m * 16 + fr;
                    const f32x4 ug = acc[ai][0][m][n], uv = acc[ai][1][m][n];
                    const f32x4 pg = (m > 0) ? acc[ai][0][m - 1][n] : ug, pv = (m > 0) ? acc[ai][1][m - 1][n] : uv;
                    f32x4 t1g, t2g, t1v, t2v, p1g, p2g, p1v, p2v;
#pragma unroll
                    for (int j = 0; j < 4; ++j) { t1g[j] = (fr == 15) ? pg[j] : ug[j]; t2g[j] = (fr >= 14) ? pg[j] : ug[j]; t1v[j] = (fr == 15) ? pv[j] : uv[j]; t2v[j] = (fr >= 14) ? pv[j] : uv[j]; }
#pragma unroll
                    for (int j = 0; j < 4; ++j) { p1g[j] = __shfl(t1g[j], src1); p2g[j] = __shfl(t2g[j], src2); p1v[j] = __shfl(t1v[j], src1); p2v[j] = __shfl(t2v[j], src2); }
                    int grow; bool valid;
                    if (SAMPLE) {
                        grow = SEQ + lr; valid = true;
                        if ((m & 1) == 0) {
                            const int b = lr >> 5;
                            if (fr < 2) { const float* s0 = state + (size_t)(b * 2) * DFF2 + gcol; const float* s1 = s0 + DFF2;
                                const f32x4 s0g = *(const f32x4*)s0, s1g = *(const f32x4*)s1, s0v = *(const f32x4*)(s0 + DFF), s1v = *(const f32x4*)(s1 + DFF);
                                if (fr == 0) { p1g = s1g; p2g = s0g; p1v = s1v; p2v = s0v; } else { p2g = s1g; p2v = s1v; } }
                        }
                        const int t = lr & 31;
                        if (t >= 30) { float* cp = convs + (size_t)((lr >> 5) * 2 + (t - 30)) * DFF2 + gcol; *(f32x4*)cp = ug; *(f32x4*)(cp + DFF) = uv; }
                    } else {
                        grow = 62 * (4 * u.pm + 2 * ai + wr) + rho - 2; valid = (rho >= 2) && (grow < SEQ);
                        if (valid && grow >= SEQ - 2) { float* cp = convp + (size_t)(grow - (SEQ - 2)) * DFF2 + gcol; *(f32x4*)cp = ug; *(f32x4*)(cp + DFF) = uv; }
                    }
                    const f32x4 cg = w2g * ug + w1g * p1g + w0g * p2g + bg, cv = w2v * uv + w1v * p1v + w0v * p2v + bv;
                    f32x4 h;
#pragma unroll
                    for (int j = 0; j < 4; ++j) h[j] = cg[j] * __builtin_amdgcn_rcpf(1.f + __builtin_amdgcn_exp2f(-LOG2E * cg[j])) * cv[j];
                    if (valid) { u32x2 w; w.x = cvtpk(h[0], h[1]); w.y = cvtpk(h[2], h[3]); *(u32x2*)(H + (size_t)grow * DFF + gcol) = w; }
                }
        }
    }
};
}

__device__ __forceinline__ int crow(int r, int hi) { return (r & 3) + 8 * (r >> 2) + 4 * hi; }
typedef short v4i16_t __attribute__((ext_vector_type(4)));
__device__ __forceinline__ s16x4 vtr(const LAS unsigned char* p) { return __builtin_bit_cast(s16x4, __builtin_amdgcn_ds_read_tr16_b64_v4i16((LAS v4i16_t*)p)); }
template <int DQ, bool BIAS>
__device__ __forceinline__ void gsa_wave(const bf16_t* Q, int qp, const bf16_t* K, int kp, const bf16_t* V, int vp, int nkeys, const float* btab, int relbase,
                                         bf16_t* O, int op, LAS unsigned char* wl, int lane) {
    const int r32 = lane & 31, hi = lane >> 5;
    LAS float* wsf = (LAS float*)(wl + 4096);
    bf16x8 qr[DQ / 16];
#pragma unroll
    for (int d0 = 0; d0 < DQ / 16; ++d0) qr[d0] = *(const bf16x8*)(Q + (size_t)r32 * qp + d0 * 16 + hi * 8);
    f32x16 o0 = {}, o1 = {};
    float mrun = -INFINITY, l = 0.f;
    const LAS unsigned char* vb = wl + (4 * hi + ((lane & 15) >> 2)) * 64 + ((lane >> 4) & 1) * 32 + (lane & 3) * 8;
    for (int k0 = 0; k0 < nkeys; k0 += 32) {
        u32x4 vreg[4];
#pragma unroll
        for (int i = 0; i < 4; ++i) { const int idx = i * 64 + lane, key = idx >> 3, ch = idx & 7; vreg[i] = *(const u32x4*)(V + (size_t)(k0 + key) * vp + ch * 8); }
        f32x16 s = {};
#pragma unroll
        for (int d0 = 0; d0 < DQ / 16; ++d0) { const bf16x8 kf = *(const bf16x8*)(K + (size_t)(k0 + r32) * kp + d0 * 16 + hi * 8); s = __builtin_amdgcn_mfma_f32_32x32x16_bf16(kf, qr[d0], s, 0, 0, 0); }
#pragma unroll
        for (int i = 0; i < 4; ++i) { const int idx = i * 64 + lane, key = idx >> 3, ch = idx & 7; *(LAS u32x4*)(wl + ((ch >> 2) * 2 + (key >> 4)) * 1024 + (key & 15) * 64 + (ch & 3) * 16) = vreg[i]; }
        if (BIAS) {
#pragma unroll
            for (int r = 0; r < 16; ++r) s[r] += btab[relbase + r32 - (k0 + crow(r, hi))];
        }
        float mx = s[0];
#pragma unroll
        for (int r = 1; r < 16; ++r) mx = fmaxf(mx, s[r]);
        mx = fmaxf(mx, __shfl_xor(mx, 32));
        const float mnew = fmaxf(mrun, mx), alpha = __builtin_amdgcn_exp2f(mrun - mnew);
        float rs = 0.f;
#pragma unroll
        for (int r = 0; r < 16; ++r) { s[r] = __builtin_amdgcn_exp2f(s[r] - mnew); rs += s[r]; }
        rs += __shfl_xor(rs, 32);
        l = l * alpha + rs; mrun = mnew;
        if (hi == 0) wsf[r32] = alpha;
        asm volatile("s_waitcnt lgkmcnt(0)" ::: "memory");
#pragma unroll
        for (int g = 0; g < 4; ++g) { const f32x4 a4 = *(const LAS f32x4*)(wsf + 8 * g + 4 * hi);
#pragma unroll
            for (int j = 0; j < 4; ++j) { o0[4 * g + j] *= a4[j]; o1[4 * g + j] *= a4[j]; } }
        u32x4 pw0, pw1;
        pw0.x = cvtpk(s[0], s[1]); pw0.y = cvtpk(s[2], s[3]); pw0.z = cvtpk(s[4], s[5]); pw0.w = cvtpk(s[6], s[7]);
        pw1.x = cvtpk(s[8], s[9]); pw1.y = cvtpk(s[10], s[11]); pw1.z = cvtpk(s[12], s[13]); pw1.w = cvtpk(s[14], s[15]);
#pragma unroll
        for (int d0 = 0; d0 < 2; ++d0)
#pragma unroll
            for (int ks = 0; ks < 2; ++ks) {
                const s16x4 lo = vtr(vb + (d0 * 2 + ks) * 1024), hh = vtr(vb + (d0 * 2 + ks) * 1024 + 512);
                const bf16x8 vf = {lo[0], lo[1], lo[2], lo[3], hh[0], hh[1], hh[2], hh[3]};
                const bf16x8 pa = __builtin_bit_cast(bf16x8, ks == 0 ? pw0 : pw1);
                if (d0 == 0) o0 = __builtin_amdgcn_mfma_f32_32x32x16_bf16(pa, vf, o0, 0, 0, 0); else o1 = __builtin_amdgcn_mfma_f32_32x32x16_bf16(pa, vf, o1, 0, 0, 0);
            }
        asm volatile("s_waitcnt lgkmcnt(0)" ::: "memory");
    }
    if (hi == 0) wsf[r32] = 1.f / l;
    asm volatile("s_waitcnt lgkmcnt(0)" ::: "memory");
#pragma unroll
    for (int r = 0; r < 16; ++r) { const int q = crow(r, hi); const float rl = wsf[q];
        O[(size_t)q * op + r32] = f2bf(o0[r] * rl); O[(size_t)q * op + 32 + r32] = f2bf(o1[r] * rl); }
    asm volatile("s_waitcnt lgkmcnt(0)" ::: "memory");
}


namespace attn_body {
constexpr int NW = 8, QBLK = 32, QB = QBLK * NW, KVBLK = 64;
#define SBAR() __builtin_amdgcn_sched_barrier(0)
constexpr int NSLOT = 3, SLOTB = 8192;
constexpr int LDS_K = 0, LDS_V = NSLOT * SLOTB, LDS_WS = 2 * NSLOT * SLOTB, LDS_OST = LDS_WS + NW * 64 * 4, LDS_BYTES = LDS_OST + NW * 4096;
__device__ __forceinline__ void glds16(const void* gsrc, unsigned lds_dst) { unsigned keep;
  asm volatile("s_mov_b32 %0, m0\n\ts_mov_b32 m0, %2\n\ts_nop 0\n\tglobal_load_lds_dwordx4 %1, off\n\ts_mov_b32 m0, %0" : "=&s"(keep) : "v"(gsrc), "s"(lds_dst) : "memory"); }
__device__ __forceinline__ float max3f(float a, float b, float c) { float r; asm("v_max3_f32 %0, %1, %2, %3" : "=v"(r) : "v"(a), "v"(b), "v"(c)); return r; }
__device__ __forceinline__ float max2f(float a, float b) { float r; asm("v_max_f32_e32 %0, %1, %2" : "=v"(r) : "v"(a), "v"(b)); return r; }
__device__ __forceinline__ float fadd_s(float a, float b) { float r; asm("v_add_f32_e32 %0, %1, %2" : "=v"(r) : "v"(a), "v"(b)); return r; }
__device__ __forceinline__ float fsub_s(float a, float b) { float r; asm("v_sub_f32_e32 %0, %1, %2" : "=v"(r) : "v"(a), "v"(b)); return r; }
#define WAIT_BAR(N) asm volatile("s_waitcnt vmcnt(" #N ") lgkmcnt(0)\n\ts_barrier" ::: "memory")
__device__ __forceinline__ void qkt(f32x16& p0, f32x16& p1, const char* Kslot, const bf16x8* qr, const f32x16& negm, int r32, int hi) {
  const char* kb = Kslot + hi * 1024 + r32 * 16;
  #pragma unroll
  for (int d0 = 0; d0 < 4; ++d0) {
    const bf16x8 b0 = *reinterpret_cast<const bf16x8*>(kb + d0 * 2048);
    const bf16x8 b1 = *reinterpret_cast<const bf16x8*>(kb + d0 * 2048 + 512);
    if (d0 == 0) { p0 = __builtin_amdgcn_mfma_f32_32x32x16_bf16(b0, qr[0], negm, 0, 0, 0); p1 = __builtin_amdgcn_mfma_f32_32x32x16_bf16(b1, qr[0], negm, 0, 0, 0); }
    else { p0 = __builtin_amdgcn_mfma_f32_32x32x16_bf16(b0, qr[d0], p0, 0, 0, 0); p1 = __builtin_amdgcn_mfma_f32_32x32x16_bf16(b1, qr[d0], p1, 0, 0, 0); } }
}
typedef __attribute__((address_space(3))) const char* lds_cptr;
__device__ __forceinline__ void kload8(bf16x8* kf, lds_cptr kp) {
  kf[0] = *(const LAS bf16x8*)(kp);        kf[1] = *(const LAS bf16x8*)(kp + 512);
  kf[2] = *(const LAS bf16x8*)(kp + 2048); kf[3] = *(const LAS bf16x8*)(kp + 2560);
  kf[4] = *(const LAS bf16x8*)(kp + 4096); kf[5] = *(const LAS bf16x8*)(kp + 4608);
  kf[6] = *(const LAS bf16x8*)(kp + 6144); kf[7] = *(const LAS bf16x8*)(kp + 6656);
}
__device__ __forceinline__ void kload2(bf16x8* kf, lds_cptr kp, int j) { kf[2 * j] = *(const LAS bf16x8*)(kp + j * 2048); kf[2 * j + 1] = *(const LAS bf16x8*)(kp + j * 2048 + 512); }
__device__ __forceinline__ s16x4 vtr(lds_cptr p) { return __builtin_bit_cast(s16x4, __builtin_amdgcn_ds_read_tr16_b64_v4i16((LAS v4i16_t*)p)); }
__device__ __forceinline__ float rowmax(const f32x16& p0, const f32x16& p1) {
  float a = max3f(p0[0], p0[1], p1[0]), b = max3f(p0[2], p0[3], p1[1]); a = max3f(a, p1[2], p1[3]);
  #pragma unroll
  for (int r = 4; r < 16; r += 4) { a = max3f(a, p0[r], p0[r + 1]); b = max3f(b, p0[r + 2], p0[r + 3]); a = max3f(a, p1[r], p1[r + 1]); b = max3f(b, p1[r + 2], p1[r + 3]); }
  const float m = max2f(a, b);
  auto rr = __builtin_amdgcn_permlane32_swap(__float_as_uint(m), __float_as_uint(m), false, false);
  return max2f(__uint_as_float(rr[0]), __uint_as_float(rr[1]));
}
__device__ __forceinline__ void pv(f32x16* o, int vb, bf16x8 pa0, bf16x8 pa1, bf16x8 pa2, bf16x8 pa3) {
  #pragma unroll
  for (int d0 = 0; d0 < 2; ++d0) { s16x4 lo[4], hi[4];
    #pragma unroll
    for (int ks = 0; ks < 4; ++ks) {
      asm volatile("ds_read_b64_tr_b16 %0,%1 offset:%c2" : "=&v"(lo[ks]) : "v"(vb), "i"(d0 * 4096 + ks * 1024) : "memory");
      asm volatile("ds_read_b64_tr_b16 %0,%1 offset:%c2" : "=&v"(hi[ks]) : "v"(vb), "i"(d0 * 4096 + ks * 1024 + 512) : "memory"); }
    asm volatile("s_waitcnt lgkmcnt(0)" ::: "memory"); SBAR();
    #define PK(k) (bf16x8){lo[k][0], lo[k][1], lo[k][2], lo[k][3], hi[k][0], hi[k][1], hi[k][2], hi[k][3]}
    o[d0] = __builtin_amdgcn_mfma_f32_32x32x16_bf16(pa0, PK(0), o[d0], 0, 0, 0);
    o[d0] = __builtin_amdgcn_mfma_f32_32x32x16_bf16(pa1, PK(1), o[d0], 0, 0, 0);
    o[d0] = __builtin_amdgcn_mfma_f32_32x32x16_bf16(pa2, PK(2), o[d0], 0, 0, 0);
    o[d0] = __builtin_amdgcn_mfma_f32_32x32x16_bf16(pa3, PK(3), o[d0], 0, 0, 0);
    #undef PK
  }
}
template <int THRL> __device__ __forceinline__ void attn_unit(int qb, const bf16_t* Qh, const bf16_t* __restrict__ Kh, const bf16_t* __restrict__ Vh, const int PQ, bf16_t* Oh, const int PO, char* shm) {
  const int tid = threadIdx.x, lane = tid & 63, r32 = lane & 31, hi = lane >> 5; const int wid = __builtin_amdgcn_readfirstlane(tid >> 6);
  const int q0 = qb * QB;
  const bf16_t* Qw = Qh + (long)(q0 + wid * QBLK) * PQ;
  const unsigned lds0 = (unsigned)(uintptr_t)shm;
  float* wsf = (float*)(shm + LDS_WS) + wid * 64;
  const bf16_t* ksrc = Kh + (long)lane * PQ + wid * 8;
  const bf16_t* vsrc = Vh + (long)(16 * (wid & 3) + (lane >> 2)) * PQ + (wid >> 2) * 32 + (lane & 3) * 8;
  const unsigned kdst = lds0 + LDS_K + wid * 1024, vdst = lds0 + LDS_V + wid * 1024;
  #define DMA_K(t, slot) glds16(ksrc + (long)(t) * KVBLK * PQ, (unsigned)__builtin_amdgcn_readfirstlane(kdst + (slot)))
  #define DMA_V(t, slot) glds16(vsrc + (long)(t) * KVBLK * PQ, (unsigned)__builtin_amdgcn_readfirstlane(vdst + (slot)))
  const int vb0 = (int)(lds0 + LDS_V) + ((lane >> 4) & 1) * 32 + (lane & 3) * 8 + (4 * hi + ((lane & 15) >> 2)) * 64;
  const char* Kbase = shm + LDS_K; bf16x8 kf[8];
  const lds_cptr shm3 = (lds_cptr)shm; const lds_cptr kp0 = shm3 + LDS_K + hi * 1024 + r32 * 16; const lds_cptr vp0 = shm3 + LDS_V + ((lane >> 4) & 1) * 32 + (lane & 3) * 8 + (4 * hi + ((lane & 15) >> 2)) * 64;
  const int NT = (q0 + QB) / KVBLK;
  DMA_K(0, 0); DMA_V(0, 0); DMA_K(1, SLOTB);
  bf16x8 qr[4];
  #pragma unroll
  for (int d0 = 0; d0 < 4; ++d0) qr[d0] = *reinterpret_cast<const bf16x8*>(&Qw[(long)r32 * PQ + d0 * 16 + hi * 8]);
  float mhat = 0.f, l_reg = 0.f; f32x16 o[2]; o[0] = f32x16{}; o[1] = f32x16{}; f32x16 negm = f32x16{}; asm volatile("" : "+v"(negm));
  const int wchunk = wid >> 1;
  #define CMASK(P0, P1, t) do { int jb_ = (t) - (NT - 4); if (jb_ > wchunk) { _Pragma("unroll") for (int r_ = 0; r_ < 16; ++r_) { P0[r_] = -INFINITY; P1[r_] = -INFINITY; } } } while (0)
  bool resc = false;
  #define START(P0, P1) do { const float rm = rowmax(P0, P1); resc = false; \
    { const float dl = rm; mhat = fadd_s(mhat, dl); \
      _Pragma("unroll") for (int r = 0; r < 16; ++r) { P0[r] = fsub_s(P0[r], dl); P1[r] = fsub_s(P1[r], dl); } \
      _Pragma("unroll") for (int r = 0; r < 16; ++r) negm[r] = -mhat; asm volatile("" : "+v"(negm)); } \
    _Pragma("unroll") for (int r = 0; r < 16; ++r) P0[r] = __builtin_amdgcn_exp2f(P0[r]); } while (0)
  #define RESC() do { if (resc) { asm volatile("s_waitcnt lgkmcnt(0)" ::: "memory"); \
      _Pragma("unroll") for (int d_ = 0; d_ < 2; ++d_) _Pragma("unroll") for (int r = 0; r < 16; ++r) o[d_][r] *= wsf[crow(r, hi)]; } } while (0)
  f32x16 pA0, pA1, pB0, pB1;
  int sl_prev = 0, sl_cur = 0, sl_next = SLOTB;
  #define ROT() do { sl_prev = sl_cur; sl_cur = sl_next; sl_next = (sl_next == (NSLOT - 1) * SLOTB) ? 0 : sl_next + SLOTB; } while (0)
  DMA_K(2, 2 * SLOTB);
  WAIT_BAR(3);
  qkt(pA0, pA1, Kbase, qr, negm, r32, hi); asm volatile("s_nop 15\n\ts_nop 7" : "+v"(pA0), "+v"(pA1)); CMASK(pA0, pA1, 0);
  START(pA0, pA1);
  _Pragma("unroll") for (int r = 0; r < 16; ++r) pA1[r] = __builtin_amdgcn_exp2f(pA1[r]);
  WAIT_BAR(0);
  DMA_K(3, 0); DMA_V(1, SLOTB);
  ROT();
  kload8(kf, kp0 + sl_cur);
  WAIT_BAR(2);
  s16x4 vlo[8], vhi[8]; u32x4 pw0, pw1, pw2, pw3;
  #define PKW(P, B) cvtpk(P[B], P[B + 1])
  #define PAF(k) __builtin_bit_cast(bf16x8, pw##k)
  #define VFR(i) (bf16x8){vlo[i][0], vlo[i][1], vlo[i][2], vlo[i][3], vhi[i][0], vhi[i][1], vhi[i][2], vhi[i][3]}
  #define PIN(x) asm volatile("" : "+v"(x))
  #define MX3(a, b, c) __builtin_fmaxf(__builtin_fmaxf((a), (b)), (c))
  #define GAPA(MF, A0, A1, A2, A3, W0, W1, PW) do { MF; sacc += A0; sacc += A1; sacc += A2; sacc += A3; PIN(sacc); W0; W1; PIN(PW); SBAR(); } while (0)
  #define EX(v) __builtin_amdgcn_exp2f(v)
  #define GAPB(MF, X, B) do { MF; X[B] = EX(X[B]); X[B + 1] = EX(X[B + 1]); X[B + 2] = EX(X[B + 2]); X[B + 3] = EX(X[B + 3]); PIN(X); SBAR(); } while (0)
  #define VRD(i) do { vlo[i] = vtr(vp_ + (((i) >> 2) * 4096 + ((i) & 3) * 1024)); vhi[i] = vtr(vp_ + (((i) >> 2) * 4096 + ((i) & 3) * 1024 + 512)); } while (0)
  #define KRD(G, j) do { if (G) { kload2(kf, kp0 + sl_next, j); SBAR(); } } while (0)
  #define STEP(C0, C1, P0, P1, t, GK, GV, GL) do { SBAR(); \
    const lds_cptr vp_ = vp0 + sl_prev; \
    VRD(0); SBAR(); float sacc = (P0[0] + P0[1]); \
    GAPA(C0 = __builtin_amdgcn_mfma_f32_32x32x16_bf16(kf[0], qr[0], negm, 0, 0, 0), P0[2], P0[3], P0[4], P0[5],     pw0[0] = PKW(P0, 0), pw0[1] = PKW(P0, 2), pw0); \
    VRD(4); SBAR(); GAPA(C1 = __builtin_amdgcn_mfma_f32_32x32x16_bf16(kf[1], qr[0], negm, 0, 0, 0), P0[6], P0[7], P0[8], P0[9],     pw0[2] = PKW(P0, 4), pw0[3] = PKW(P0, 6), pw0); \
    VRD(1); SBAR(); GAPA(C0 = __builtin_amdgcn_mfma_f32_32x32x16_bf16(kf[2], qr[1], C0, 0, 0, 0),   P0[10], P0[11], P0[12], P0[13], pw1[0] = PKW(P0, 8), pw1[1] = PKW(P0, 10), pw1); \
    VRD(5); SBAR(); GAPA(C1 = __builtin_amdgcn_mfma_f32_32x32x16_bf16(kf[3], qr[1], C1, 0, 0, 0),   P0[14], P0[15], P1[0], P1[1],   pw1[2] = PKW(P0, 12), pw1[3] = PKW(P0, 14), pw1); \
    VRD(2); SBAR(); GAPA(C0 = __builtin_amdgcn_mfma_f32_32x32x16_bf16(kf[4], qr[2], C0, 0, 0, 0),   P1[2], P1[3], P1[4], P1[5],     pw2[0] = PKW(P1, 0), pw2[1] = PKW(P1, 2), pw2); \
    VRD(6); SBAR(); GAPA(C1 = __builtin_amdgcn_mfma_f32_32x32x16_bf16(kf[5], qr[2], C1, 0, 0, 0),   P1[6], P1[7], P1[8], P1[9],     pw2[2] = PKW(P1, 4), pw2[3] = PKW(P1, 6), pw2); \
    VRD(3); SBAR(); GAPA(C0 = __builtin_amdgcn_mfma_f32_32x32x16_bf16(kf[6], qr[3], C0, 0, 0, 0),   P1[10], P1[11], P1[12], P1[13], pw3[0] = PKW(P1, 8), pw3[1] = PKW(P1, 10), pw3); \
    VRD(7); SBAR(); GAPA(C1 = __builtin_amdgcn_mfma_f32_32x32x16_bf16(kf[7], qr[3], C1, 0, 0, 0),   P1[14], P1[15], 0.f, 0.f,       pw3[2] = PKW(P1, 12), pw3[3] = PKW(P1, 14), pw3); \
    l_reg += sacc; \
    if (GK) { DMA_K((t) + 3, sl_cur); } if (GV) { DMA_V((t) + 1, sl_next); } \
    CMASK(C0, C1, t); \
    { float a = MX3(C0[0], C0[1], C1[0]), b = MX3(C0[2], C0[3], C1[1]); a = MX3(a, C1[2], C1[3]); \
      _Pragma("unroll") for (int r = 4; r < 16; r += 4) { a = MX3(a, C0[r], C0[r + 1]); b = MX3(b, C0[r + 2], C0[r + 3]); a = MX3(a, C1[r], C1[r + 1]); b = MX3(b, C1[r + 2], C1[r + 3]); } \
      float rm = __builtin_fmaxf(a, b); { auto rr = __builtin_amdgcn_permlane32_swap(__float_as_uint(rm), __float_as_uint(rm), false, false); rm = __builtin_fmaxf(__uint_as_float(rr[0]), __uint_as_float(rr[1])); } \
      resc = false; \
      if (__builtin_expect(__any(rm > (float)THRL), 0)) { const float dl = __builtin_fmaxf(rm, 0.f); mhat += dl; \
        _Pragma("unroll") for (int r = 0; r < 16; ++r) { C0[r] -= dl; C1[r] -= dl; } \
        _Pragma("unroll") for (int r = 0; r < 16; ++r) negm[r] = -mhat; asm volatile("" : "+v"(negm)); \
        const float f = __builtin_amdgcn_exp2f(-dl); l_reg *= f; if (hi == 0) wsf[r32] = f; resc = true; } } \
    SBAR(); \
    GAPB(o[0] = __builtin_amdgcn_mfma_f32_32x32x16_bf16(PAF(0), VFR(0), o[0], 0, 0, 0), C0, 0); \
    GAPB(o[1] = __builtin_amdgcn_mfma_f32_32x32x16_bf16(PAF(0), VFR(4), o[1], 0, 0, 0), C0, 4); \
    KRD(GL, 0); GAPB(o[0] = __builtin_amdgcn_mfma_f32_32x32x16_bf16(PAF(1), VFR(1), o[0], 0, 0, 0), C0, 8); \
    KRD(GL, 1); GAPB(o[1] = __builtin_amdgcn_mfma_f32_32x32x16_bf16(PAF(1), VFR(5), o[1], 0, 0, 0), C0, 12); \
    KRD(GL, 2); GAPB(o[0] = __builtin_amdgcn_mfma_f32_32x32x16_bf16(PAF(2), VFR(2), o[0], 0, 0, 0), C1, 0); \
    KRD(GL, 3); GAPB(o[1] = __builtin_amdgcn_mfma_f32_32x32x16_bf16(PAF(2), VFR(6), o[1], 0, 0, 0), C1, 4); \
    GAPB(o[0] = __builtin_amdgcn_mfma_f32_32x32x16_bf16(PAF(3), VFR(3), o[0], 0, 0, 0), C1, 8); \
    GAPB(o[1] = __builtin_amdgcn_mfma_f32_32x32x16_bf16(PAF(3), VFR(7), o[1], 0, 0, 0), C1, 12); \
    } while (0)
  int t = 1;
  #undef CMASK
  #define CMASK(P0, P1, t) do {} while (0)
  for (; t + 5 < NT; t += 2) {
    STEP(pB0, pB1, pA0, pA1, t, true, true, true);     WAIT_BAR(2); RESC(); ROT();
    STEP(pA0, pA1, pB0, pB1, t + 1, true, true, true); WAIT_BAR(2); RESC(); ROT();
  }
  #undef CMASK
  #define CMASK(P0, P1, t) do { int jb_ = (t) - (NT - 4); if (jb_ > wchunk) { _Pragma("unroll") for (int r_ = 0; r_ < 16; ++r_) { P0[r_] = -INFINITY; P1[r_] = -INFINITY; } } } while (0)
  #define ENDW(tt) do { if ((tt) + 3 < NT) { WAIT_BAR(2); } else if ((tt) + 2 < NT) { WAIT_BAR(1); } else { WAIT_BAR(0); } } while (0)
  for (; t + 1 < NT; t += 2) {
    STEP(pB0, pB1, pA0, pA1, t, (t + 3 < NT), (t + 1 < NT), (t + 1 < NT));         ENDW(t);     RESC(); ROT();
    STEP(pA0, pA1, pB0, pB1, t + 1, (t + 4 < NT), (t + 2 < NT), (t + 2 < NT));     ENDW(t + 1); RESC(); ROT();
  }
  STEP(pB0, pB1, pA0, pA1, NT - 1, false, false, false); RESC();
  { float sacc = pB0[0] + pB0[1]; _Pragma("unroll") for (int r = 2; r < 16; ++r) sacc += pB0[r]; _Pragma("unroll") for (int r = 0; r < 16; ++r) sacc += pB1[r]; l_reg += sacc;
    pw0 = (u32x4){PKW(pB0, 0), PKW(pB0, 2), PKW(pB0, 4), PKW(pB0, 6)}; pw1 = (u32x4){PKW(pB0, 8), PKW(pB0, 10), PKW(pB0, 12), PKW(pB0, 14)}; pw2 = (u32x4){PKW(pB1, 0), PKW(pB1, 2), PKW(pB1, 4), PKW(pB1, 6)}; pw3 = (u32x4){PKW(pB1, 8), PKW(pB1, 10), PKW(pB1, 12), PKW(pB1, 14)};
    SBAR(); pv(o, vb0 + sl_cur, PAF(0), PAF(1), PAF(2), PAF(3)); }
  #undef PKW
  #undef PAF
  #undef VFR
  #undef PIN
  #undef MX3
  #undef GAPA
  #undef GAPB
  #undef EX
  #undef VRD
  #undef KRD
  #undef STEP
  #undef ENDW
  { auto rr = __builtin_amdgcn_permlane32_swap(__float_as_uint(l_reg), __float_as_uint(l_reg), false, false); l_reg = __uint_as_float(rr[0]) + __uint_as_float(rr[1]); }
  if (hi == 0) wsf[32 + r32] = l_reg; asm volatile("s_waitcnt lgkmcnt(0)" ::: "memory");
  float rli[16];
  #pragma unroll
  for (int r = 0; r < 16; ++r) rli[r] = __builtin_amdgcn_rcpf(wsf[32 + crow(r, hi)]);
  bf16_t* Ow = Oh + (long)(q0 + wid * QBLK) * PO;
  { bf16_t* stg = (bf16_t*)(shm + LDS_OST) + wid * 2048;
    #pragma unroll
    for (int r = 0; r < 16; ++r) { const int orow = crow(r, hi);
      #pragma unroll
      for (int d0 = 0; d0 < 2; ++d0) stg[orow * 64 + d0 * 32 + r32] = f2bf(o[d0][r] * rli[r]); }
    asm volatile("s_waitcnt lgkmcnt(0)" ::: "memory");
    #pragma unroll
    for (int i = 0; i < 4; ++i) { const int row = i * 8 + (lane >> 3), ch = lane & 7; const u32x4 v = *(const u32x4*)(stg + row * 64 + ch * 8); *(u32x4*)(Ow + (long)row * PO + ch * 8) = v; } }
  asm volatile("s_waitcnt lgkmcnt(0)\n\ts_barrier" ::: "memory");
  #undef DMA_K
  #undef DMA_V
  #undef CMASK
  #undef START
  #undef RESC
  #undef ROT
}
#undef SBAR
#undef WAIT_BAR
}

typedef GAS unsigned gu32;
#define RLX_AGENT __ATOMIC_RELAXED, __HIP_MEMORY_SCOPE_AGENT
#define XB_TMO      128
#define XB_XCNT(j)  (256  + 64 * (j))
#define XB_XSUB(j)  (1280 + 64 * (j))
#define XB_XGEN(j)  (2304 + 64 * (j))
#define XB_TOP      3328
#define XB_TOPGEN   3392
#define XCD_BAR_WORDS 3456
#define XB_SPIN_CAP (1u << 18)
__device__ __forceinline__ unsigned xb_ld(unsigned* p)              { return __hip_atomic_load(p, __ATOMIC_RELAXED, __HIP_MEMORY_SCOPE_AGENT); }
__device__ __forceinline__ unsigned xb_add(unsigned* p, unsigned v) { return __hip_atomic_fetch_add(p, v, __ATOMIC_RELAXED, __HIP_MEMORY_SCOPE_AGENT); }
__device__ __forceinline__ unsigned xb_xcc_id() { return (unsigned)__builtin_amdgcn_s_getreg((3 << 11) | 20) & 0xFu; }
#define XB_SPIN(cond, bar) do { unsigned _sp = 0; while (cond) { __builtin_amdgcn_s_sleep(1); \
    if ((++_sp & 255u) == 0u) { if (xb_ld(&(bar)[XB_TMO])) break; if (_sp > XB_SPIN_CAP) { atomicAdd(&(bar)[XB_TMO], 1u); break; } } } } while (0)
struct XcdBarrier { unsigned* bar; unsigned x; volatile LAS unsigned* st; };
__device__ __forceinline__ XcdBarrier xcd_barrier_post(unsigned* bar, volatile LAS unsigned* st) {
    XcdBarrier b; b.bar = bar; b.x = xb_xcc_id(); b.st = st;
    if (threadIdx.x == 0) (void)xb_add(&bar[XB_XCNT(b.x)], 1u);
    return b;
}
__device__ __forceinline__ void xcd_barrier_complete(unsigned* bar, unsigned x, unsigned& nloc, unsigned& nx) {
    const unsigned G = gridDim.x * gridDim.y * gridDim.z;
    unsigned sum, cnt, mine, sp = 0u;
    for (;;) {
        sum = 0u; cnt = 0u; mine = 0u;
#pragma unroll
        for (unsigned j = 0; j < 16; ++j) { const unsigned c = xb_ld(&bar[XB_XCNT(j)]); sum += c; cnt += (c > 0u) ? 1u : 0u; mine = (j == x) ? c : mine; }
        if (sum == G) break;
        __builtin_amdgcn_s_sleep(1);
        if ((++sp & 255u) == 0u) { if (xb_ld(&bar[XB_TMO])) break; if (sp > XB_SPIN_CAP) { atomicAdd(&bar[XB_TMO], 1u); break; } }
    }
    nloc = mine > 0u ? mine : 1u; nx = cnt > 0u ? cnt : 1u;
}
__device__ __forceinline__ void xcd_barrier(const XcdBarrier& b) {
    asm volatile("s_waitcnt vmcnt(0)" ::: "memory");
    __syncthreads();
    if (threadIdx.x == 0) {
        unsigned* bar = b.bar;
        __builtin_amdgcn_s_waitcnt(0);
        unsigned nloc = b.st[0], nx = b.st[1];
        if (nloc == 0u) { xcd_barrier_complete(bar, b.x, nloc, nx); b.st[0] = nloc; b.st[1] = nx; }
        const unsigned old = xb_add(&bar[XB_XSUB(b.x)], 1u);
        const unsigned gen = old / nloc;
        if (old + 1u == (gen + 1u) * nloc) {
            __builtin_amdgcn_fence(__ATOMIC_RELEASE, "agent");
            asm volatile("s_waitcnt vmcnt(0)" ::: "memory");
            const unsigned og = xb_add(&bar[XB_TOP], 1u);
            const unsigned tg = og / nx;
            if (og + 1u == (tg + 1u) * nx) xb_add(&bar[XB_TOPGEN], 1u);
            else XB_SPIN(xb_ld(&bar[XB_TOPGEN]) == tg, bar);
            __builtin_amdgcn_fence(__ATOMIC_ACQUIRE, "agent");
            xb_add(&bar[XB_XGEN(b.x)], 1u);
            asm volatile("s_waitcnt vmcnt(0)" ::: "memory");
        } else {
            XB_SPIN(xb_ld(&bar[XB_XGEN(b.x)]) == gen, bar);
            __builtin_amdgcn_fence(__ATOMIC_ACQUIRE, "agent");
            asm volatile("s_waitcnt vmcnt(0)" ::: "memory");
        }
    }
    __syncthreads();
}

__device__ __forceinline__ void team_barrier(unsigned* cnt, unsigned target) {
    asm volatile("s_waitcnt vmcnt(0)" ::: "memory");
    __syncthreads();
    if (threadIdx.x == 0) {
        __builtin_amdgcn_fence(__ATOMIC_RELEASE, "agent");
        asm volatile("s_waitcnt vmcnt(0)" ::: "memory");
        xb_add(cnt, 1u);
        unsigned sp = 0;
        while (xb_ld(cnt) < target) { __builtin_amdgcn_s_sleep(2); if (++sp > (1u << 22)) break; }
        __builtin_amdgcn_fence(__ATOMIC_ACQUIRE, "agent");
        asm volatile("s_waitcnt vmcnt(0)" ::: "memory");
    }
    __syncthreads();
}

constexpr int NWAVES = 8;
constexpr int RING_BYTES = 131072, LDSCTL_OFF = RING_BYTES, MISC_OFF = LDSCTL_OFF + 320, LDS_BYTES = 147456;
constexpr int CW_BAR = 4096;
constexpr int NPHASE = 13;
#ifndef MK_N_LAUNCHES
#define MK_N_LAUNCHES 1
#endif
#ifndef PROBE_DUP
#define PROBE_DUP -1
#endif
#define REP(k) for (int rep_ = 0; rep_ < 1 + (PROBE_DUP == (k) ? 1 : 0); ++rep_)
constexpr int N_LAUNCHES = MK_N_LAUNCHES;

#define LDS_WAIT() asm volatile("s_waitcnt lgkmcnt(0)" ::: "memory")
__device__ __forceinline__ float wave_sum(float v) {
#pragma unroll
    for (int o = 1; o < 64; o <<= 1) v += __shfl_xor(v, o);
    return v;
}
__device__ __forceinline__ void p0_transpose_item(const float* W, int K, int N, bf16_t* WT, int k0, int n0, int orow0, LAS float* scr, int lane) {
#pragma unroll 8
    for (int i = 0; i < 32; ++i) { const int kk = 2 * i + (lane >> 5); scr[kk * 33 + (lane & 31)] = W[(size_t)(k0 + kk) * N + n0 + (lane & 31)]; }
    LDS_WAIT(); asm volatile("" ::: "memory");
    const int c = lane & 7;
#pragma unroll
    for (int j = 0; j < 4; ++j) { const int n = (lane >> 3) + 8 * j; const LAS float* s = scr + (8 * c) * 33 + n;
        u32x4 o; o.x = cvtpk(s[0 * 33], s[1 * 33]); o.y = cvtpk(s[2 * 33], s[3 * 33]); o.z = cvtpk(s[4 * 33], s[5 * 33]); o.w = cvtpk(s[6 * 33], s[7 * 33]);
        *(u32x4*)(WT + (size_t)(orow0 + n) * K + k0 + 8 * c) = o; }
    LDS_WAIT(); asm volatile("" ::: "memory");
}
__device__ __forceinline__ void sincos_d(double a, double& s, double& c) {
    const double k = __builtin_rint(a * 0.63661977236758134308);
    double r = __builtin_fma(-k, 1.57079632679489655800e+00, a); r = __builtin_fma(-k, 6.12323399573676603587e-17, r);
    const double r2 = r * r;
    double sp = -7.6471637318198164759e-13; sp = sp * r2 + 1.6059043836821614599e-10; sp = sp * r2 - 2.5052108385441718775e-08; sp = sp * r2 + 2.7557319223985890653e-06;
    sp = sp * r2 - 1.9841269841269841270e-04; sp = sp * r2 + 8.3333333333333333333e-03; sp = sp * r2 - 1.6666666666666666667e-01; const double sr = r + r * r2 * sp;
    double cp = 4.7794773323873852974e-14; cp = cp * r2 - 1.1470745597729724714e-11; cp = cp * r2 + 2.0876756987868098979e-09; cp = cp * r2 - 2.7557319223985890653e-07;
    cp = cp * r2 + 2.4801587301587301587e-05; cp = cp * r2 - 1.3888888888888888889e-03; cp = cp * r2 + 4.1666666666666666667e-02; cp = cp * r2 - 0.5; const double cr = 1.0 + r2 * cp;
    const int q = ((int)k) & 3;
    s = (q == 0) ? sr : (q == 1) ? cr : (q == 2) ? -sr : -cr;
    c = (q == 0) ? cr : (q == 1) ? -sr : (q == 2) ? -cr : sr;
}

struct Args { const float* in[32]; float* out; unsigned char* ws; int ph_lo, ph_hi, li, pad; };

__global__ void __launch_bounds__(NWAVES * 64, 2) mk_fwd(Args args) {
    extern __shared__ __attribute__((aligned(16))) unsigned char lds_raw[];
    LAS unsigned char* lds = (LAS unsigned char*)lds_raw;
    volatile LAS unsigned* MISC = (volatile LAS unsigned*)(lds + MISC_OFF);
    const int tid = threadIdx.x, lane = tid & 63, wave = __builtin_amdgcn_readfirstlane(tid >> 6);
    const int G = gridDim.x, bx = blockIdx.x;
    const int gw = bx * NWAVES + wave, NGW = G * NWAVES;
    unsigned char* ws = args.ws; float* out = args.out;
    gu32* ctl = (gu32*)(ws + WS_CTL);
    for (int u = tid; u < (LDS_BYTES - LDSCTL_OFF) / 4; u += NWAVES * 64) ((LAS unsigned*)(lds + LDSCTL_OFF))[u] = 0u;
    __syncthreads();
    XcdBarrier bar; bar.bar = (unsigned*)(ctl + CW_BAR); bar.x = 0; bar.st = nullptr;
    if (N_LAUNCHES == 1) bar = xcd_barrier_post((unsigned*)(ctl + CW_BAR), MISC + 8);
#define GRID_BAR() do { if (N_LAUNCHES == 1) xcd_barrier(bar); } while (0)
    const int lo = args.ph_lo, hi_ph = args.ph_hi;
#define IN(k) (lo <= (k) && (k) < hi_ph)
#define SEAM(k) do { if (IN(k) && IN((k) + 1)) GRID_BAR(); } while (0)

    const float* x_prompt = args.in[0]; const float* x_sample = args.in[1]; const float* mem_prompt = args.in[2];
#define Wqkv_t ((bf16_t*)(ws + WS_WQKV))
#define Wo_t ((bf16_t*)(ws + WS_WO))
#define Wmq_t ((bf16_t*)(ws + WS_WMQ))
#define Wmkv_t ((bf16_t*)(ws + WS_WMKV))
#define Wmo_t ((bf16_t*)(ws + WS_WMO))
#define Wup_t ((bf16_t*)(ws + WS_WUP))
#define Wdn_t ((bf16_t*)(ws + WS_WDN))
#define MEMB ((bf16_t*)(ws + WS_MEMB))
#define MKB ((bf16_t*)(ws + WS_MKB))
#define MVB ((bf16_t*)(ws + WS_MVB))
#define KAS ((bf16_t*)(ws + WS_KAS))
#define VAS ((bf16_t*)(ws + WS_VAS))
#define KBS ((bf16_t*)(ws + WS_KBS))
#define VBS ((bf16_t*)(ws + WS_VBS))
#define MKS ((bf16_t*)(ws + WS_MKS))
#define MVS ((bf16_t*)(ws + WS_MVS))
#define QKVB ((bf16_t*)(ws + WS_QKVB))
#define XB ((bf16_t*)(ws + WS_XB))
#define OD ((bf16_t*)(ws + WS_OD))
#define MIXA ((bf16_t*)(ws + WS_MIXA))
#define X1B ((bf16_t*)(ws + WS_X1B))
#define X2B ((bf16_t*)(ws + WS_X2B))
#define QM ((bf16_t*)(ws + WS_QM))
#define OM ((bf16_t*)(ws + WS_OM))
#define HB ((bf16_t*)(ws + WS_H))
#define ROPE ((float*)(ws + WS_ROPE))
#define BT ((float*)(ws + WS_BT))
#define LAMP ((float*)(ws + WS_LAM))
    float* R = out + OFF_Y;

#define LN_PASS(gp, bp, XO, r0, r1, w_, nw_) do { \
        for (int m = (r0) + (w_); m < (r1); m += (nw_)) { \
            f32x4* xr = (f32x4*)(R + (size_t)m * DM) + lane; f32x4 v[4]; float s = 0.f; \
            _Pragma("unroll") for (int j = 0; j < 4; ++j) { v[j] = xr[64 * j]; s += (v[j][0] + v[j][1]) + (v[j][2] + v[j][3]); } \
            const float mean = wave_sum(s) * (1.f / DM); float s2 = 0.f; \
            _Pragma("unroll") for (int j = 0; j < 4; ++j) { v[j] = v[j] - mean; s2 += (v[j][0] * v[j][0] + v[j][1] * v[j][1]) + (v[j][2] * v[j][2] + v[j][3] * v[j][3]); } \
            const float rstd = 1.f / sqrtf(wave_sum(s2) * (1.f / DM) + LN_EPS); \
            _Pragma("unroll") for (int j = 0; j < 4; ++j) { const f32x4 gg = *((const f32x4*)(gp) + lane + 64 * j), bb = *((const f32x4*)(bp) + lane + 64 * j); \
                const f32x4 y = v[j] * rstd * gg + bb; xr[64 * j] = y; \
                if (XO) { u32x2 w; w.x = cvtpk(y[0], y[1]); w.y = cvtpk(y[2], y[3]); *((u32x2*)((bf16_t*)(XO) + (size_t)m * DM) + lane + 64 * j) = w; } } \
        } } while (0)
#define COMBINE_ROWS(ODp, MXp, r0, r1, w_, nw_) do { \
        const float lam = LAMP[0]; const int h = lane >> 4, d0 = (lane & 15) * 8; \
        const f32x4 g0 = *(const f32x4*)(args.in[16] + d0), g1 = *(const f32x4*)(args.in[16] + d0 + 4); \
        for (int m = (r0) + (w_); m < (r1); m += (nw_)) { \
            const u32x4 a = *(const u32x4*)((ODp) + (size_t)m * DM + h * 256 + d0), b = *(const u32x4*)((ODp) + (size_t)m * DM + h * 256 + 128 + d0); \
            float o[8]; float ss = 0.f; \
            _Pragma("unroll") for (int j = 0; j < 4; ++j) { const unsigned ua = a[j], ub = b[j]; \
                o[2 * j] = __uint_as_float(ua << 16) - lam * __uint_as_float(ub << 16); o[2 * j + 1] = __uint_as_float(ua & 0xffff0000u) - lam * __uint_as_float(ub & 0xffff0000u); \
                ss += o[2 * j] * o[2 * j] + o[2 * j + 1] * o[2 * j + 1]; } \
            ss += __shfl_xor(ss, 1); ss += __shfl_xor(ss, 2); ss += __shfl_xor(ss, 4); ss += __shfl_xor(ss, 8); \
            const float rn = 0.8f / sqrtf(ss * (1.f / 128.f) + LN_EPS); \
            u32x4 w; w.x = cvtpk(o[0] * rn * g0[0], o[1] * rn * g0[1]); w.y = cvtpk(o[2] * rn * g0[2], o[3] * rn * g0[3]); w.z = cvtpk(o[4] * rn * g1[0], o[5] * rn * g1[1]); w.w = cvtpk(o[6] * rn * g1[2], o[7] * rn * g1[3]); \
            *(u32x4*)((MXp) + (size_t)m * DM + 512 + h * 128 + d0) = w; \
        } } while (0)
    if (IN(0)) REP(0) {
        LAS float* scr = (LAS float*)(lds + wave * 16384);
        {
            constexpr int I_QKV = 16 * 96, I_SQ = 16 * 32, I_UP = 16 * 176, I_DN = 44 * 32;
            constexpr int NITEMS = I_QKV + 5 * I_SQ + I_UP + I_DN;
            for (int it = gw; it < NITEMS; it += NGW) {
                int r = it;
                if (r < I_QKV) { const int kb = r / 96, nb = r % 96; p0_transpose_item(args.in[10], 1024, 3072, Wqkv_t, kb * 64, nb * 32, nb * 32, scr, lane); continue; } r -= I_QKV;
                if (r < I_SQ) { const int kb = r / 32, nb = r % 32; p0_transpose_item(args.in[17], 1024, 1024, Wo_t, kb * 64, nb * 32, nb * 32, scr, lane); continue; } r -= I_SQ;
                if (r < I_SQ) { const int kb = r / 32, nb = r % 32; p0_transpose_item(args.in[20], 1024, 1024, Wmq_t, kb * 64, nb * 32, nb * 32, scr, lane); continue; } r -= I_SQ;
                if (r < I_SQ) { const int kb = r / 32, nb = r % 32; p0_transpose_item(args.in[21], 1024, 1024, Wmkv_t, kb * 64, nb * 32, nb * 32, scr, lane); continue; } r -= I_SQ;
                if (r < I_SQ) { const int kb = r / 32, nb = r % 32; p0_transpose_item(args.in[22], 1024, 1024, Wmkv_t, kb * 64, nb * 32, 1024 + nb * 32, scr, lane); continue; } r -= I_SQ;
                if (r < I_SQ) { const int kb = r / 32, nb = r % 32; p0_transpose_item(args.in[23], 1024, 1024, Wmo_t, kb * 64, nb * 32, nb * 32, scr, lane); continue; } r -= I_SQ;
                if (r < I_UP) { const int kb = r / 176, nb = r % 176, n0 = nb * 32, bj = n0 / DFF, f = n0 % DFF; p0_transpose_item(args.in[26], 1024, DFF2, Wup_t, kb * 64, n0, 256 * (f / 128) + 128 * bj + (f % 128), scr, lane); continue; } r -= I_UP;
                { const int kb = r / 32, nb = r % 32; p0_transpose_item(args.in[29], DFF, 1024, Wdn_t, kb * 64, nb * 32, nb * 32, scr, lane); }
            }
        }
        for (int m = gw; m < MROWS + 256; m += NGW) {
            const float* src = (m < SEQ) ? x_prompt + (size_t)m * DM : (m < MROWS) ? x_sample + (size_t)(m - SEQ) * DM : mem_prompt + (size_t)(m - MROWS) * DM;
            bf16_t* dst = (m < MROWS) ? XB + (size_t)m * DM : MEMB + (size_t)(m - MROWS) * DM;
#pragma unroll
            for (int j = 0; j < 4; ++j) { const f32x4 v = *((const f32x4*)src + lane + 64 * j); u32x2 w; w.x = cvtpk(v[0], v[1]); w.y = cvtpk(v[2], v[3]); *((u32x2*)dst + lane + 64 * j) = w; }
        }
        {
            const int gt = bx * (NWAVES * 64) + tid, NT = G * NWAVES * 64;
            for (int i = gt; i < 8 * 512 * 128; i += NT) { const int b = i / (512 * 128), rem = i % (512 * 128);
                const f32x4 a = *((const f32x4*)args.in[3] + i), v = *((const f32x4*)args.in[4] + i); u32x2 w;
                w.x = cvtpk(a[0], a[1]); w.y = cvtpk(a[2], a[3]); *(u32x2*)(KAS + (size_t)b * 544 * 512 + (size_t)rem * 4) = w;
                w.x = cvtpk(v[0], v[1]); w.y = cvtpk(v[2], v[3]); *(u32x2*)(VAS + (size_t)b * 544 * 512 + (size_t)rem * 4) = w; }
            for (int i = gt; i < 8 * 1024 * 128; i += NT) { const int b = i / (1024 * 128), rem = i % (1024 * 128);
                const f32x4 a = *((const f32x4*)args.in[5] + i), v = *((const f32x4*)args.in[6] + i); u32x2 w;
                w.x = cvtpk(a[0], a[1]); w.y = cvtpk(a[2], a[3]); *(u32x2*)(KBS + (size_t)b * 1056 * 512 + (size_t)rem * 4) = w;
                w.x = cvtpk(v[0], v[1]); w.y = cvtpk(v[2], v[3]); *(u32x2*)(VBS + (size_t)b * 1056 * 512 + (size_t)rem * 4) = w; }
            for (int i = gt; i < 8 * 256 * 256; i += NT) {
                const f32x4 a = *((const f32x4*)args.in[7] + i), v = *((const f32x4*)args.in[8] + i); u32x2 w;
                w.x = cvtpk(a[0], a[1]); w.y = cvtpk(a[2], a[3]); *(u32x2*)(MKS + (size_t)i * 4) = w;
                w.x = cvtpk(v[0], v[1]); w.y = cvtpk(v[2], v[3]); *(u32x2*)(MVS + (size_t)i * 4) = w; }
            for (int i = gt; i < SEQ * 8; i += NT) { const int pos = i >> 3, j = i & 7;
                const double inv = (j == 0) ? 1.0 : (j == 1) ? 0.19392274474868576 : (j == 2) ? 0.03760603093086393 : (j == 3) ? 0.007292664737217109 : (j == 4) ? 0.001414213562373095 :
                                   (j == 5) ? 0.0002742481756762073 : (j == 6) ? 5.318295896944988e-05 : 1.031338537721246e-05;
                double s, c; sincos_d((double)pos * inv, s, c); ROPE[(size_t)pos * 16 + j] = (float)c; ROPE[(size_t)pos * 16 + 8 + j] = (float)s; }
            for (int i = gt; i < 8 * 640; i += NT) { const int h = i / 640, rel = (i % 640) - 63; const int cl = rel < -128 ? -128 : (rel > 128 ? 128 : rel);
                BT[i] = args.in[11][h * 257 + cl + 128] * LOG2E; }
            if (gt == 0) { float s1 = 0.f, s2 = 0.f; for (int d = 0; d < 64; ++d) { s1 += args.in[12][d] * args.in[13][d]; s2 += args.in[14][d] * args.in[15][d]; }
                LAMP[0] = expf(s1) - expf(s2) + 0.2f; }
        }
    }
    SEAM(0);
    if (IN(1)) REP(1) {
        pg8::Gemm g{XB, Wqkv_t, DM, DM, DM}; pg8::StaticOrder S; S.init(64, 12, G, bx);
        pg8::EpiQKV E{QKVB, out, ROPE, KAS, VAS, KBS, VBS};
        pg8::gemm_phase<pg8::EpiQKV, 0, true, true>(lds, g, S, E);
    }
    SEAM(1);
    if (IN(2)) {
      const int xcd = bx & 7, jx = bx >> 3;
      if (jx < TEAM_J0) {
        LAS unsigned char* wl = lds + wave * 8192;
        REP(2) {
            for (int k = 0; k < 5; ++k) {
                const int i = (k & 1) ? (k + 1) * TEAM_J0 - 1 - jx : k * TEAM_J0 + jx;
                if (i >= 128) break;
                const int qb = 63 - (i >> 1), vh = i & 1, hm = xcd;
                attn_body::attn_unit<8>(qb, (const bf16_t*)(ws + WS_QKVB) + 1536 + hm * 64, (const bf16_t*)(ws + WS_QKVB) + 2048 + hm * 64, (const bf16_t*)(ws + WS_QKVB) + 2560 + (hm >> 1) * 128 + vh * 64, NQKV,
                                        (bf16_t*)(ws + WS_OD) + hm * 128 + vh * 64, DM, (char*)lds_raw);
            }
            __syncthreads();
        }
        const int agw = (xcd * TEAM_J0 + jx) * NWAVES + wave, ANW = 8 * TEAM_J0 * NWAVES;
        REP(20) for (int u = agw; u < 4096; u += ANW) {
            const int qblk = u >> 3, h = u & 7, c = qblk >> 1, klo = (64 * c - 512) < 0 ? 0 : (64 * c - 512), nk = 64 * c + 64 - klo;
            gsa_wave<64, true>(QKVB + (size_t)(qblk * 32) * NQKV + h * 64, NQKV, QKVB + (size_t)klo * NQKV + 512 + h * 64, NQKV, QKVB + (size_t)klo * NQKV + 1024 + h * 64, NQKV, nk,
                               BT + h * 640, qblk * 32 - klo + 63, MIXA + (size_t)(qblk * 32) * DM + h * 64, DM, wl, lane);
        }
      } else {
        const int ts = (jx - TEAM_J0) * 8 + xcd, tgw = ts * NWAVES + wave, TNW = TEAM_S * NWAVES;
        unsigned tb = 0;
#define TEAM_BAR() do { ++tb; team_barrier((unsigned*)(ctl + CW_TEAM), (unsigned)TEAM_S * tb); } while (0)
        LAS unsigned char* wl = lds + wave * 8192;
        bf16_t* SQKV = (bf16_t*)(ws + WS_SQKV); bf16_t* SMIXA = (bf16_t*)(ws + WS_SMIXA); bf16_t* SOD = (bf16_t*)(ws + WS_SOD);
        { pg8::Gemm g{XB, Wqkv_t, DM, DM, DM}; pg8::StaticOrder S; S.init(1, 12, TEAM_S, ts, 64);
          pg8::EpiQKV E{SQKV - (size_t)SEQ * NQKV, out, ROPE, KAS, VAS, KBS, VBS};
          pg8::gemm_phase<pg8::EpiQKV, 0, true, true>(lds, g, S, E); }
        { pg8::Gemm g{MEMB, Wmkv_t, DM, DM, DM}; pg8::StaticOrder S; S.init(1, 8, TEAM_S, (ts + TEAM_S - 12) % TEAM_S);
          pg8::EpiMemKV E{out, MKB, MVB};
          pg8::gemm_phase<pg8::EpiMemKV, 0, true, true>(lds, g, S, E); }
        TEAM_BAR();
        for (int u = tgw; u < 192; u += TNW) {
            if (u < 64) { const int b = u >> 3, h = u & 7;
                gsa_wave<64, true>(SQKV + (size_t)(b * 32) * NQKV + h * 64, NQKV, KAS + (size_t)b * 544 * 512 + h * 64, 512, VAS + (size_t)b * 544 * 512 + h * 64, 512, 544,
                                   BT + h * 640, 512 + 63, SMIXA + (size_t)(b * 32) * DM + h * 64, DM, wl, lane);
            } else { const int v = u - 64, b = v >> 4, hmv = v & 15, hm = hmv >> 1, vh = hmv & 1;
                gsa_wave<64, false>(SQKV + (size_t)(b * 32) * NQKV + 1536 + hm * 64, NQKV, KBS + (size_t)b * 1056 * 512 + hm * 64, 512, VBS + (size_t)b * 1056 * 512 + (hm >> 1) * 128 + vh * 64, 512, 1056,
                                    nullptr, 0, SOD + (size_t)(b * 32) * DM + hm * 128 + vh * 64, DM, wl, lane);
            }
        }
        TEAM_BAR();
        COMBINE_ROWS(SOD, SMIXA, 0, NSAMP, tgw, TNW);
        TEAM_BAR();
        { pg8::Gemm g{SMIXA - (size_t)SEQ * DM, Wo_t, DM, DM, DM}; pg8::StaticOrder S; S.init(1, 4, TEAM_S, ts, 64);
          pg8::EpiResid E{x_prompt, x_sample, R};
          pg8::gemm_phase<pg8::EpiResid, 0, true, true>(lds, g, S, E); }
        TEAM_BAR();
        LN_PASS(args.in[18], args.in[19], (bf16_t*)(ws + WS_SX1B) - (size_t)SEQ * DM, SEQ, MROWS, tgw, TNW);
        TEAM_BAR();
        { pg8::Gemm g{(bf16_t*)(ws + WS_SX1B) - (size_t)SEQ * DM, Wmq_t, DM, DM, DM}; pg8::StaticOrder S; S.init(1, 4, TEAM_S, ts, 64);
          pg8::EpiBf16S E{(bf16_t*)(ws + WS_SQM) - (size_t)SEQ * DM, DM, C2M};
          pg8::gemm_phase<pg8::EpiBf16S, 0, true, true>(lds, g, S, E); }
        TEAM_BAR();
        for (int u = tgw; u < 128; u += TNW) { const int b = u >> 4, h = (u >> 2) & 3, vc = u & 3;
            gsa_wave<256, false>((bf16_t*)(ws + WS_SQM) + (size_t)(b * 32) * DM + h * 256, DM, MKS + (size_t)b * 256 * 1024 + h * 256, DM, MVS + (size_t)b * 256 * 1024 + h * 256 + vc * 64, DM, 256, nullptr, 0,
                                 (bf16_t*)(ws + WS_SOM) + (size_t)(b * 32) * DM + h * 256 + vc * 64, DM, wl, lane); }
        TEAM_BAR();
        { pg8::Gemm g{(bf16_t*)(ws + WS_SOM) - (size_t)SEQ * DM, Wmo_t, DM, DM, DM}; pg8::StaticOrder S; S.init(1, 4, TEAM_S, ts, 64);
          pg8::EpiResid E{R, R + (size_t)SEQ * DM, R};
          pg8::gemm_phase<pg8::EpiResid, 0, true, true>(lds, g, S, E); }
        TEAM_BAR();
        LN_PASS(args.in[24], args.in[25], (bf16_t*)(ws + WS_SX2B) - (size_t)SEQ * DM, SEQ, MROWS, tgw, TNW);
        TEAM_BAR();
        { pg8::Gemm g{(bf16_t*)(ws + WS_SX2B), Wup_t, DM, DM, DM}; pg8::StaticOrder S; S.init(1, 22, TEAM_S, ts);
          pg8::EpiUpConv<true> E{(bf16_t*)(ws + WS_SH) - (size_t)SEQ * DFF, args.in[27], args.in[28], args.in[9], out + OFF_CVP, out + OFF_CVS};
          pg8::gemm_phase<pg8::EpiUpConv<true>, 0, true, true>(lds, g, S, E); }
        TEAM_BAR();
        { pg8::Gemm g{(bf16_t*)(ws + WS_SH) - (size_t)SEQ * DFF, Wdn_t, DFF, DFF, DFF}; pg8::StaticOrder S; S.init(1, 4, TEAM_S, ts, 64);
          pg8::EpiResid E{R, R + (size_t)SEQ * DM, R};
          pg8::gemm_phase<pg8::EpiResid, 0, true, true>(lds, g, S, E); }
        TEAM_BAR();
        LN_PASS(args.in[30], args.in[31], (bf16_t*)nullptr, SEQ, MROWS, tgw, TNW);
#undef TEAM_BAR
      }
    }
    SEAM(2);
    if (IN(3)) REP(3) { COMBINE_ROWS(OD, MIXA, 0, SEQ, gw, NGW); }
    SEAM(3);
    if (IN(4)) REP(4) {
        pg8::Gemm g{MIXA, Wo_t, DM, DM, DM}; pg8::StaticOrder S; S.init(64, 4, G, bx);
        pg8::EpiResid E{x_prompt, x_sample, R};
        pg8::gemm_phase<pg8::EpiResid, 0, true, true>(lds, g, S, E);
    }
    SEAM(4);
    if (IN(5)) { LN_PASS(args.in[18], args.in[19], X1B, 0, SEQ, gw, NGW); }
    SEAM(5);
    if (IN(6)) REP(6) {
        pg8::Gemm g{X1B, Wmq_t, DM, DM, DM}; pg8::StaticOrder S; S.init(64, 4, G, bx);
        pg8::EpiBf16S E{QM, DM, C2M};
        pg8::gemm_phase<pg8::EpiBf16S, 0, true, true>(lds, g, S, E);
    }
    SEAM(6);
    if (IN(7)) REP(7) {
        LAS unsigned char* wl = lds + wave * 8192;
        for (int u = gw; u < 512 * 16; u += NGW) {
            const int qblk = u >> 4, h = (u >> 2) & 3, vc = u & 3;
            gsa_wave<256, false>(QM + (size_t)(qblk * 32) * DM + h * 256, DM, MKB + h * 256, DM, MVB + h * 256 + vc * 64, DM, 256, nullptr, 0, OM + (size_t)(qblk * 32) * DM + h * 256 + vc * 64, DM, wl, lane);
        }
    }
    SEAM(7);
    if (IN(8)) {
        pg8::Gemm g{OM, Wmo_t, DM, DM, DM}; pg8::StaticOrder S; S.init(64, 4, G, bx);
        pg8::EpiResid E{R, R + (size_t)SEQ * DM, R};
        pg8::gemm_phase<pg8::EpiResid, 0, true, true>(lds, g, S, E);
    }
    SEAM(8);
    if (IN(9)) {
        if (bx == 0) { for (int i = tid; i < 1024; i += NWAVES * 64) ((unsigned*)(ws + WS_X2B - 4096))[i] = 0u; }
        LN_PASS(args.in[24], args.in[25], X2B, 0, SEQ, gw, NGW);
    }
    SEAM(9);
    if (IN(10)) REP(10) {
        { pg8::Gemm g{X2B, Wup_t, DM, DM, DM}; pg8::StaticOrder S; S.init(67, 22, G, bx);
          pg8::EpiUpConv<false> E{HB, args.in[27], args.in[28], args.in[9], out + OFF_CVP, out + OFF_CVS};
          pg8::gemm_phase<pg8::EpiUpConv<false>, 1, true, true>(lds, g, S, E); }
    }
    SEAM(10);
    if (IN(11)) {
        pg8::Gemm g{HB, Wdn_t, DFF, DFF, DFF}; pg8::StaticOrder S; S.init(64, 4, G, bx);
        pg8::EpiResid E{R, R + (size_t)SEQ * DM, R};
        pg8::gemm_phase<pg8::EpiResid, 0, true, true>(lds, g, S, E);
    }
    SEAM(11);
    if (IN(12)) { LN_PASS(args.in[30], args.in[31], (bf16_t*)nullptr, 0, SEQ, gw, NGW); }
#undef IN
#undef SEAM
}

extern "C" void kernel_launch(void* const* d_in, const int* in_sizes, int n_in, void* d_out, int out_size, void* d_ws, size_t ws_size, hipStream_t stream) {
    static int grid = 0;
    if (grid == 0) {
        int dev = 0, cus = 0;
        if (hipGetDevice(&dev) != hipSuccess || hipDeviceGetAttribute(&cus, hipDeviceAttributeMultiprocessorCount, dev) != hipSuccess) { fprintf(stderr, "kernel_launch: device query failed\n"); grid = -1; return; }
        if (hipFuncSetAttribute((const void*)mk_fwd, hipFuncAttributeMaxDynamicSharedMemorySize, LDS_BYTES) != hipSuccess) { fprintf(stderr, "kernel_launch: hipFuncSetAttribute failed\n"); grid = -1; return; }
        int per_cu = 0;
        if (hipOccupancyMaxActiveBlocksPerMultiprocessor(&per_cu, (const void*)mk_fwd, NWAVES * 64, LDS_BYTES) != hipSuccess || per_cu < 1) fprintf(stderr, "kernel_launch: occupancy query reports %d\n", per_cu);
        (void)hipGetLastError();
        grid = cus;
        fprintf(stderr, "kernel_launch: grid %d, ws %zu, n_in %d, out %d\n", grid, ws_size, n_in, out_size);
    }
    if (grid < 0) return;
    (void)hipMemsetAsync((char*)d_ws + WS_CTL, 0, CTL_ZERO_BYTES, stream);
    Args a{};
    for (int i = 0; i < 32; ++i) a.in[i] = (const float*)d_in[i];
    a.out = (float*)d_out; a.ws = (unsigned char*)d_ws;
    if (N_LAUNCHES == 1) { a.ph_lo = 0; a.ph_hi = NPHASE; a.li = 0; hipLaunchKernelGGL(mk_fwd, dim3(grid), dim3(NWAVES * 64), LDS_BYTES, stream, a); }
    else for (int li = 0; li < NPHASE; ++li) { a.ph_lo = li; a.ph_hi = li + 1; a.li = li; hipLaunchKernelGGL(mk_fwd, dim3(grid), dim3(NWAVES * 64), LDS_BYTES, stream, a); }
}
```

```cpp
#include <hip/hip_runtime.h>
#include <cstdio>
#include <cstdint>

#define LAS __attribute__((address_space(3)))
#define GAS __attribute__((address_space(1)))
typedef unsigned short bf16_t;
typedef short bf16x8 __attribute__((ext_vector_type(8)));
typedef short s16x4 __attribute__((ext_vector_type(4)));
typedef float f32x2 __attribute__((ext_vector_type(2)));
typedef float f32x4 __attribute__((ext_vector_type(4)));
typedef float f32x16 __attribute__((ext_vector_type(16)));
typedef unsigned u32x2 __attribute__((ext_vector_type(2)));
typedef unsigned u32x4 __attribute__((ext_vector_type(4)));
typedef __bf16 bf16x2_t __attribute__((ext_vector_type(2)));

constexpr int DM = 1024, SEQ = 16384, NSAMP = 256, MROWS = SEQ + NSAMP;
constexpr int NQKV = 3072, DFF = 2816, DFF2 = 5632;
constexpr float LN_EPS = 1e-5f;
constexpr float ALPHA = 1.189207115002721f;
constexpr float LOG2E = 1.4426950408889634f;
constexpr float C2 = 0.125f * LOG2E;
constexpr float C2M = 0.0625f * LOG2E;
constexpr size_t OFF_Y = 0, OFF_AKP = 17039360, OFF_AVP = 17301504, OFF_BKP = 17563648, OFF_BVP = 25952256, OFF_MKP = 34340864, OFF_MVP = 34603008,
                 OFF_CVP = 34865152, OFF_AKS = 34876416, OFF_AVS = 35007488, OFF_BKS = 35138560, OFF_BVS = 35269632, OFF_CVS = 35400704;
constexpr size_t MiB = 1u << 20;
constexpr size_t WS_CTL = 0, CTL_ZERO_BYTES = 1 * MiB;
constexpr size_t WS_ROPE = 1 * MiB, WS_BT = 2 * MiB, WS_LAM = 2 * MiB + 32768;
constexpr size_t WS_WQKV = 3 * MiB, WS_WO = 9 * MiB, WS_WMQ = 11 * MiB, WS_WMKV = 13 * MiB, WS_WMO = 17 * MiB, WS_WUP = 19 * MiB, WS_WDN = 30 * MiB;
constexpr size_t WS_MEMB = 36 * MiB, WS_MKB = 36 * MiB + 512 * 1024, WS_MVB = 37 * MiB;
constexpr size_t WS_KAS = 38 * MiB, WS_VAS = 42 * MiB + 512 * 1024, WS_KBS = 47 * MiB, WS_VBS = 55 * MiB + 512 * 1024, WS_MKS = 64 * MiB, WS_MVS = 68 * MiB;
constexpr size_t WS_QKVB = 72 * MiB, WS_XB = 170 * MiB, WS_OD = 170 * MiB, WS_MIXA = 203 * MiB, WS_X1B = 203 * MiB, WS_X2B = 203 * MiB + 4096;
constexpr size_t WS_QM = 72 * MiB, WS_OM = 105 * MiB, WS_H = 72 * MiB;
constexpr size_t WS_SQKV = 236 * MiB, WS_SMIXA = 238 * MiB, WS_SOD = 238 * MiB + 512 * 1024, WS_SX1B = 239 * MiB, WS_SX2B = 239 * MiB + 512 * 1024, WS_SQM = 240 * MiB, WS_SOM = 240 * MiB + 512 * 1024, WS_SH = 241 * MiB;
constexpr size_t WS_MVT = 37 * MiB + 512 * 1024, WS_PM = 138 * MiB;
constexpr int CW_TEAM = 8192;
constexpr int TEAM_S = 24, TEAM_J0 = 29;

__device__ __forceinline__ unsigned cvtpk(float lo, float hi) { f32x2 v = {lo, hi}; bf16x2_t b = __builtin_convertvector(v, bf16x2_t); return __builtin_bit_cast(unsigned, b); }
__device__ __forceinline__ bf16_t f2bf(float f) { return (bf16_t)(cvtpk(f, 0.f) & 0xffffu); }

namespace pg8 {
constexpr int BM = 256, BK = 64, HALF = 128, HTB = HALF * BK * 2, STAGE_BYTES = 8 * HTB, NXCD = 8, WGM = 8;
__host__ __device__ __forceinline__ int lds_byte(int r, int c) { const int st = (r >> 4) * 2 + (c >> 5), rr = r & 15, cc = c & 31, ob = rr * 64 + cc * 2; return st * 1024 + (ob ^ (((ob >> 9) & 1) << 5)); }
__host__ __device__ __forceinline__ void stage_rc(int b, int& R, int& C) { const int st = b / 1024, sb = b % 1024, swz = sb ^ (((sb >> 9) & 1) << 5); R = (st >> 1) * 16 + swz / 64; C = (st & 1) * 32 + (swz % 64) / 2; }
__host__ __device__ __forceinline__ int perm32(int rho) { const int n = rho >> 4, i = rho & 15; return 8 * (i >> 2) + 4 * n + (i & 3); }
struct Unit { int pm, pn; };
struct Gemm { const bf16_t* A; const bf16_t* Bt; int lda, ldb, K; };
struct StaticOrder {
    int nM, nN, nwg, G, c, pm0;
    __host__ __device__ __forceinline__ void init(int nM_, int nN_, int G_, int c_, int pm0_ = 0) { nM = nM_; nN = nN_; nwg = nM * nN; G = G_; c = c_; pm0 = pm0_; }
    __host__ __device__ __forceinline__ bool next(int i, Unit& u) const {
        const long L = (long)i * G + c; if (L >= nwg) return false;
        int wgid = (int)L; { const int q = nwg / NXCD, r = nwg % NXCD, xcd = wgid % NXCD, off = wgid / NXCD; wgid = (xcd < r ? xcd * (q + 1) : r * (q + 1) + (xcd - r) * q) + off; }
        const int nig = WGM * nN, gid = wgid / nig, fm = gid * WGM, gsz = (nM - fm) < WGM ? (nM - fm) : WGM;
        u.pm = pm0 + fm + ((wgid % nig) % gsz); u.pn = (wgid % nig) / gsz; return true;
    }
};
template <class Epi, int AMODE, bool ALIGN_EPI, bool SP2>
__device__ __forceinline__ void gemm_phase(LAS unsigned char* lds, const Gemm g, const StaticOrder& S, const Epi& E) {
    int tid_ = threadIdx.x; asm volatile("" : "+v"(tid_));
    const int tid = tid_, wid = __builtin_amdgcn_readfirstlane(tid >> 6), lane = tid & 63, wr = wid >> 2, wc = wid & 3, fr = lane & 15, fq = lane >> 4;
    const int K = g.K, nt = K / BK;
    unsigned voffA[2], voffB[2];
#pragma unroll
    for (int i = 0; i < 2; ++i) { int R, C; stage_rc(tid * 16 + i * 8192, R, C); const int Rb = Epi::PERM ? ((R & ~31) + perm32(R & 31)) : R;
        const int Ra = (AMODE == 1) ? (62 * (R >> 6) + (R & 63)) : R;
        voffA[i] = (unsigned)(Ra * g.lda + C) * 2u; voffB[i] = (unsigned)(Rb * g.ldb + C) * 2u; }
    const size_t kstep = (size_t)(BK * 2);
    const size_t hstepA = (size_t)((AMODE == 1) ? 124 : 128) * g.lda * 2, hstepB = (size_t)HALF * g.ldb * 2;
    const unsigned ldsw = (unsigned)wid * 1024u;
    const int aoff = lds_byte(wr * 64 + fr, fq * 8), boff = lds_byte(wc * 32 + fr, fq * 8);
#define PG8_TILEA(pm) ((const char*)g.A + (ptrdiff_t)((AMODE == 1) ? (248 * (pm) - 2) : (256 * (pm))) * g.lda * 2)
#define PG8_TILEB(pn) ((const char*)g.Bt + (size_t)(256 * (pn)) * g.ldb * 2)
#define PG8_SA(b, h) (((b) * 2 + (h)) * HTB)
#define PG8_SB(b, h) ((4 + (b) * 2 + (h)) * HTB)
#define PG8_STAGE(bufoff, gbase, voff) do { _Pragma("unroll") for (int _i = 0; _i < 2; ++_i) \
        __builtin_amdgcn_global_load_lds((const unsigned*)((const char*)(gbase) + (voff)[_i]), (LAS unsigned*)(lds + (bufoff) + ldsw + _i * 8192), 16, 0, 0); } while (0)
#define PG8_LDA(dst, b, h) do { _Pragma("unroll") for (int m = 0; m < 4; ++m) _Pragma("unroll") for (int k = 0; k < 2; ++k) dst[m][k] = *(const LAS bf16x8*)(lds + PG8_SA(b, h) + aoff + m * 2048 + k * 1024); } while (0)
#define PG8_LDB(dst, b, h) do { _Pragma("unroll") for (int n = 0; n < 2; ++n) _Pragma("unroll") for (int k = 0; k < 2; ++k) dst[n][k] = *(const LAS bf16x8*)(lds + PG8_SB(b, h) + boff + n * 2048 + k * 1024); } while (0)
#define PG8_MMA(ai, bj, At, Bt) do { __builtin_amdgcn_s_setprio(1); _Pragma("unroll") for (int m = 0; m < 4; ++m) _Pragma("unroll") for (int n = 0; n < 2; ++n) _Pragma("unroll") for (int k = 0; k < 2; ++k) \
        acc[ai][bj][m][n] = __builtin_amdgcn_mfma_f32_16x16x32_bf16(Bt[n][k], At[m][k], acc[ai][bj][m][n], 0, 0, 0); __builtin_amdgcn_s_setprio(0); } while (0)
#define PG8_WAIT_V(n) asm volatile("s_waitcnt vmcnt(" #n ")" ::: "memory")
#define PG8_WAIT_L(n) asm volatile("s_waitcnt lgkmcnt(" #n ")" ::: "memory")
#define PG8_BAR __builtin_amdgcn_s_barrier()
#define PG8_SCHED __builtin_amdgcn_sched_barrier(0)
    Unit cur, nxt; int ui = 0;
    if (!S.next(0, cur)) return;
    f32x4 acc[2][2][4][2];
#pragma unroll
    for (int a = 0; a < 2; ++a)
#pragma unroll
        for (int b = 0; b < 2; ++b)
#pragma unroll
            for (int m = 0; m < 4; ++m)
#pragma unroll
                for (int n = 0; n < 2; ++n) acc[a][b][m][n] = (f32x4){0.f, 0.f, 0.f, 0.f};
    bf16x8 At[4][2], B0[2][2], B1[2][2];
    const char* cA = PG8_TILEA(cur.pm); const char* cB = PG8_TILEB(cur.pn);
    if constexpr (SP2) {
        PG8_STAGE(PG8_SB(0, 0), cB, voffB); PG8_STAGE(PG8_SB(0, 1), cB + hstepB, voffB); PG8_STAGE(PG8_SA(0, 0), cA, voffA); PG8_STAGE(PG8_SA(0, 1), cA + hstepA, voffA);
        if (wr == 1) PG8_BAR;
        PG8_WAIT_V(2); PG8_BAR;
        PG8_STAGE(PG8_SB(1, 0), cB + kstep, voffB); PG8_STAGE(PG8_SA(1, 0), cA + kstep, voffA); PG8_STAGE(PG8_SB(1, 1), cB + hstepB + kstep, voffB);
        PG8_WAIT_V(6); PG8_BAR;
    } else {
        PG8_STAGE(PG8_SB(0, 0), cB, voffB); PG8_STAGE(PG8_SA(0, 0), cA, voffA); PG8_STAGE(PG8_SB(0, 1), cB + hstepB, voffB); PG8_STAGE(PG8_SA(0, 1), cA + hstepA, voffA);
        if (wr == 1) PG8_BAR;
        PG8_WAIT_V(4); PG8_BAR;
        PG8_STAGE(PG8_SB(1, 0), cB + kstep, voffB); PG8_STAGE(PG8_SA(1, 0), cA + kstep, voffA); PG8_STAGE(PG8_SB(1, 1), cB + hstepB + kstep, voffB);
        PG8_WAIT_V(6); PG8_BAR;
    }
    for (;;) {
        const bool has_next = S.next(ui + 1, nxt);
        const char* nA = has_next ? PG8_TILEA(nxt.pm) : cA; const char* nB = has_next ? PG8_TILEB(nxt.pn) : cB;
        for (int t = 0; t < nt; t += 2) {
            const bool last = (t == nt - 2);
            const char* a1 = cA + (size_t)(t + 1) * kstep;
            const char* a2 = last ? nA : cA + (size_t)(t + 2) * kstep; const char* b2 = last ? nB : cB + (size_t)(t + 2) * kstep;
            const char* a3 = a2 + kstep; const char* b3 = b2 + kstep;
            if constexpr (SP2) {
            PG8_LDB(B0, 0, 0); PG8_LDB(B1, 0, 1); PG8_SCHED; PG8_LDA(At, 0, 0); PG8_STAGE(PG8_SA(1, 1), a1 + hstepA, voffA);
            PG8_WAIT_V(8); PG8_WAIT_L(0); PG8_BAR; PG8_MMA(0, 0, At, B0); PG8_MMA(0, 1, At, B1); PG8_BAR; PG8_SCHED;
            PG8_LDA(At, 0, 1); PG8_STAGE(PG8_SB(0, 0), b2, voffB); PG8_STAGE(PG8_SB(0, 1), b2 + hstepB, voffB); PG8_STAGE(PG8_SA(0, 0), a2, voffA);
            PG8_WAIT_V(8); PG8_WAIT_L(0); PG8_BAR; PG8_MMA(1, 0, At, B0); PG8_MMA(1, 1, At, B1); PG8_BAR; PG8_SCHED;
            PG8_LDB(B0, 1, 0); PG8_LDB(B1, 1, 1); PG8_SCHED; PG8_LDA(At, 1, 0); PG8_STAGE(PG8_SA(0, 1), a2 + hstepA, voffA);
            PG8_WAIT_V(8); PG8_WAIT_L(0); PG8_BAR; PG8_MMA(0, 0, At, B0); PG8_MMA(0, 1, At, B1); PG8_BAR; PG8_SCHED;
            PG8_LDA(At, 1, 1); PG8_STAGE(PG8_SB(1, 0), b3, voffB); PG8_STAGE(PG8_SB(1, 1), b3 + hstepB, voffB); PG8_STAGE(PG8_SA(1, 0), a3, voffA);
            PG8_WAIT_V(8); PG8_WAIT_L(0); PG8_BAR; PG8_MMA(1, 0, At, B0); PG8_MMA(1, 1, At, B1); PG8_BAR; PG8_SCHED;
            } else {
            PG8_LDB(B0, 0, 0); PG8_SCHED; PG8_LDA(At, 0, 0); PG8_STAGE(PG8_SA(1, 1), a1 + hstepA, voffA);
            PG8_WAIT_L(8); PG8_BAR; PG8_WAIT_L(0); PG8_MMA(0, 0, At, B0); PG8_BAR; PG8_SCHED;
            PG8_LDB(B1, 0, 1); PG8_STAGE(PG8_SB(0, 0), b2, voffB);
            PG8_BAR; PG8_WAIT_L(0); PG8_MMA(0, 1, At, B1); PG8_BAR;
            PG8_LDA(At, 0, 1); PG8_STAGE(PG8_SA(0, 0), a2, voffA);
            PG8_BAR; PG8_WAIT_L(0); PG8_MMA(1, 0, At, B0); PG8_BAR; PG8_SCHED;
            PG8_STAGE(PG8_SB(0, 1), b2 + hstepB, voffB);
            PG8_WAIT_V(6); PG8_BAR; PG8_MMA(1, 1, At, B1); PG8_BAR;
            PG8_LDB(B0, 1, 0); PG8_SCHED; PG8_LDA(At, 1, 0); PG8_STAGE(PG8_SA(0, 1), a2 + hstepA, voffA);
            PG8_WAIT_L(8); PG8_BAR; PG8_WAIT_L(0); PG8_MMA(0, 0, At, B0); PG8_BAR; PG8_SCHED;
            PG8_LDB(B1, 1, 1); PG8_STAGE(PG8_SB(1, 0), b3, voffB);
            PG8_BAR; PG8_WAIT_L(0); PG8_MMA(0, 1, At, B1); PG8_BAR;
            PG8_LDA(At, 1, 1); PG8_STAGE(PG8_SA(1, 0), a3, voffA);
            PG8_BAR; PG8_WAIT_L(0); PG8_MMA(1, 0, At, B0); PG8_BAR; PG8_SCHED;
            PG8_STAGE(PG8_SB(1, 1), b3 + hstepB, voffB);
            PG8_WAIT_V(6); PG8_BAR; PG8_MMA(1, 1, At, B1); PG8_BAR;
            }
        }
        if constexpr (ALIGN_EPI) { if (wr == 0) PG8_BAR; }
        E(acc, cur, wr, wc, fr, fq);
        if (!has_next) break;
#pragma unroll
        for (int a = 0; a < 2; ++a)
#pragma unroll
            for (int b = 0; b < 2; ++b)
#pragma unroll
                for (int m = 0; m < 4; ++m)
#pragma unroll
                    for (int n = 0; n < 2; ++n) acc[a][b][m][n] = (f32x4){0.f, 0.f, 0.f, 0.f};
        cur = nxt; cA = nA; cB = nB; ++ui;
        if constexpr (ALIGN_EPI) { if (wr == 1) PG8_BAR; }
    }
    PG8_WAIT_V(0);
    if constexpr (!ALIGN_EPI) { if (wr == 0) PG8_BAR; }
    PG8_BAR;
#undef PG8_TILEA
#undef PG8_TILEB
#undef PG8_SA
#undef PG8_SB
#undef PG8_STAGE
#undef PG8_LDA
#undef PG8_LDB
#undef PG8_MMA
#undef PG8_WAIT_V
#undef PG8_WAIT_L
#undef PG8_BAR
#undef PG8_SCHED
}

struct EpiQKV {
    static constexpr bool PERM = true;
    bf16_t* qkvb; float* out; const float* rope; bf16_t *kas, *vas, *kbs, *vbs;
    __device__ __forceinline__ void operator()(const f32x4 (&acc)[2][2][4][2], const Unit& u, int wr, int wc, int fr, int fq) const {
        const int pn = u.pn, pm = u.pm, region = pn >> 1;
        const bool isq = (region == 0) || (region == 3);
        const float sc = isq ? C2 : 1.f;
        const bool rope_on = (pn >= 6 && pn < 10) && ((wc & 1) == 0);
#pragma unroll
        for (int ai = 0; ai < 2; ++ai)
#pragma unroll
            for (int m = 0; m < 4; ++m) {
                const int lr = ai * 128 + wr * 64 + m * 16 + fr, grow = pm * 256 + lr;
                f32x4 cs0 = {1.f, 1.f, 1.f, 1.f}, cs1 = cs0, sn0 = {0.f, 0.f, 0.f, 0.f}, sn1 = sn0;
                if (rope_on) { const int pos = (grow < SEQ) ? grow : 1024 + ((grow - SEQ) & 31); const f32x4* rp = (const f32x4*)(rope + (size_t)pos * 16);
                    cs0 = rp[0]; cs1 = rp[1]; sn0 = rp[2]; sn1 = rp[3]; }
#pragma unroll
                for (int bj = 0; bj < 2; ++bj) {
                    f32x4 v0 = acc[ai][bj][m][0], v1 = acc[ai][bj][m][1];
                    const int c8 = pn * 256 + bj * 128 + wc * 32 + fq * 8, cr = c8 - region * 512;
                    if (rope_on) {
                        f32x4 p0, p1;
#pragma unroll
                        for (int j = 0; j < 4; ++j) { p0[j] = __shfl_xor(v0[j], 16); p1[j] = __shfl_xor(v1[j], 16); }
                        if (fq == 0) { v0 = v0 * cs0 - p0 * sn0; v1 = v1 * cs1 - p1 * sn1; }
                        else if (fq == 1) { v0 = v0 * cs0 + p0 * sn0; v1 = v1 * cs1 + p1 * sn1; }
                    }
                    float* fo = nullptr;
                    if (region == 1 || region == 2) {
                        if (pm == 64) fo = out + (region == 1 ? OFF_AKS : OFF_AVS) + (size_t)(grow - SEQ) * 512 + cr;
                        else if (grow >= SEQ - 512) fo = out + (region == 1 ? OFF_AKP : OFF_AVP) + (size_t)(grow - (SEQ - 512)) * 512 + cr;
                    } else if (region == 4 || region == 5) {
                        if (pm == 64) fo = out + (region == 4 ? OFF_BKS : OFF_BVS) + (size_t)(grow - SEQ) * 512 + cr;
                        else fo = out + (region == 4 ? OFF_BKP : OFF_BVP) + (size_t)grow * 512 + cr;
                    }
                    if (fo) { *(f32x4*)fo = v0; *(f32x4*)(fo + 4) = v1; }
                    u32x4 w; w.x = cvtpk(v0[0] * sc, v0[1] * sc); w.y = cvtpk(v0[2] * sc, v0[3] * sc); w.z = cvtpk(v1[0] * sc, v1[1] * sc); w.w = cvtpk(v1[2] * sc, v1[3] * sc);
                    *(u32x4*)(qkvb + (size_t)grow * NQKV + c8) = w;
                    if (pm == 64) { const int b = (grow - SEQ) >> 5, t = (grow - SEQ) & 31;
                        if (region == 1) *(u32x4*)(kas + ((size_t)(b * 544 + 512 + t)) * 512 + cr) = w;
                        else if (region == 2) *(u32x4*)(vas + ((size_t)(b * 544 + 512 + t)) * 512 + cr) = w;
                        else if (region == 4) *(u32x4*)(kbs + ((size_t)(b * 1056 + 1024 + t)) * 512 + cr) = w;
                        else if (region == 5) *(u32x4*)(vbs + ((size_t)(b * 1056 + 1024 + t)) * 512 + cr) = w; }
                }
            }
    }
};
struct EpiMemKV {
    static constexpr bool PERM = true;
    float* out; bf16_t *mkb, *mvb, *mvt;
    __device__ __forceinline__ void operator()(const f32x4 (&acc)[2][2][4][2], const Unit& u, int wr, int wc, int fr, int fq) const {
        const bool isv = u.pn >= 4;
        float* fb = out + (isv ? OFF_MVP : OFF_MKP); bf16_t* bb = isv ? mvb : mkb;
#pragma unroll
        for (int ai = 0; ai < 2; ++ai)
#pragma unroll
            for (int m = 0; m < 4; ++m) { const int lr = ai * 128 + wr * 64 + m * 16 + fr;
#pragma unroll
                for (int bj = 0; bj < 2; ++bj) { const f32x4 v0 = acc[ai][bj][m][0], v1 = acc[ai][bj][m][1];
                    const int c8 = (u.pn & 3) * 256 + bj * 128 + wc * 32 + fq * 8;
                    *(f32x4*)(fb + (size_t)lr * 1024 + c8) = v0; *(f32x4*)(fb + (size_t)lr * 1024 + c8 + 4) = v1;
                    u32x4 w; w.x = cvtpk(v0[0], v0[1]); w.y = cvtpk(v0[2], v0[3]); w.z = cvtpk(v1[0], v1[1]); w.w = cvtpk(v1[2], v1[3]);
                    *(u32x4*)(bb + (size_t)lr * 1024 + c8) = w;
                    if (isv) {
#pragma unroll
                        for (int j = 0; j < 4; ++j) { mvt[(size_t)(c8 + j) * 256 + lr] = f2bf(v0[j]); mvt[(size_t)(c8 + 4 + j) * 256 + lr] = f2bf(v1[j]); } }
                } }
    }
};
struct EpiSoftmax {
    static constexpr bool PERM = true;
    bf16_t* P; int ldp; LAS unsigned char* xl;
    __device__ __forceinline__ void operator()(f32x4 (&acc)[2][2][4][2], const Unit& u, int wr, int wc, int fr, int fq) const {
        LAS float* MX = (LAS float*)xl; LAS float* SM = MX + 1024;
#pragma unroll
        for (int ai = 0; ai < 2; ++ai)
#pragma unroll
            for (int m = 0; m < 4; ++m) { float v = -INFINITY;
#pragma unroll
                for (int bj = 0; bj < 2; ++bj)
#pragma unroll
                    for (int n = 0; n < 2; ++n) { const f32x4 x = acc[ai][bj][m][n]; v = fmaxf(v, fmaxf(fmaxf(x[0], x[1]), fmaxf(x[2], x[3]))); }
                v = fmaxf(v, __shfl_xor(v, 16)); v = fmaxf(v, __shfl_xor(v, 32));
                if (fq == 0) MX[(ai * 128 + wr * 64 + m * 16 + fr) * 4 + wc] = v; }
        asm volatile("s_waitcnt lgkmcnt(0)" ::: "memory"); __builtin_amdgcn_s_barrier(); asm volatile("" ::: "memory");
#pragma unroll
        for (int ai = 0; ai < 2; ++ai)
#pragma unroll
            for (int m = 0; m < 4; ++m) { const int row = ai * 128 + wr * 64 + m * 16 + fr; const f32x4 t = *(const LAS f32x4*)(MX + row * 4);
                const float M = fmaxf(fmaxf(t[0], t[1]), fmaxf(t[2], t[3])); float s = 0.f;
#pragma unroll
                for (int bj = 0; bj < 2; ++bj)
#pragma unroll
                    for (int n = 0; n < 2; ++n) { f32x4 x = acc[ai][bj][m][n];
#pragma unroll
                        for (int j = 0; j < 4; ++j) { x[j] = __builtin_amdgcn_exp2f(x[j] - M); s += x[j]; }
                        acc[ai][bj][m][n] = x; }
                s += __shfl_xor(s, 16); s += __shfl_xor(s, 32);
                if (fq == 0) SM[row * 4 + wc] = s; }
        asm volatile("s_waitcnt lgkmcnt(0)" ::: "memory"); __builtin_amdgcn_s_barrier(); asm volatile("" ::: "memory");
#pragma unroll
        for (int ai = 0; ai < 2; ++ai)
#pragma unroll
            for (int m = 0; m < 4; ++m) { const int row = ai * 128 + wr * 64 + m * 16 + fr, grow = u.pm * 256 + row; const f32x4 t = *(const LAS f32x4*)(SM + row * 4);
                const float inv = 1.f / ((t[0] + t[1]) + (t[2] + t[3]));
#pragma unroll
                for (int bj = 0; bj < 2; ++bj) { const f32x4 v0 = acc[ai][bj][m][0] * inv, v1 = acc[ai][bj][m][1] * inv;
                    u32x4 w; w.x = cvtpk(v0[0], v0[1]); w.y = cvtpk(v0[2], v0[3]); w.z = cvtpk(v1[0], v1[1]); w.w = cvtpk(v1[2], v1[3]);
                    *(u32x4*)(P + (size_t)grow * ldp + bj * 128 + wc * 32 + fq * 8) = w; } }
        asm volatile("s_waitcnt lgkmcnt(0)" ::: "memory"); __builtin_amdgcn_s_barrier(); asm volatile("" ::: "memory");
    }
};
struct EpiResid {
    static constexpr bool PERM = false;
    const float* base0; const float* base1; float* out;
    __device__ __forceinline__ void operator()(const f32x4 (&acc)[2][2][4][2], const Unit& u, int wr, int wc, int fr, int fq) const {
#pragma unroll
        for (int ai = 0; ai < 2; ++ai)
#pragma unroll
            for (int m = 0; m < 4; ++m) { const int grow = u.pm * 256 + ai * 128 + wr * 64 + m * 16 + fr;
                const float* bp = (u.pm < 64) ? base0 + (size_t)grow * DM : base1 + (size_t)(grow - SEQ) * DM; float* op = out + (size_t)grow * DM;
#pragma unroll
                for (int bj = 0; bj < 2; ++bj)
#pragma unroll
                    for (int n = 0; n < 2; ++n) { const int col = u.pn * 256 + bj * 128 + wc * 32 + n * 16 + fq * 4;
                        const f32x4 b = *(const f32x4*)(bp + col); *(f32x4*)(op + col) = b * ALPHA + acc[ai][bj][m][n]; } }
    }
};
struct EpiBf16S {
    static constexpr bool PERM = true;
    bf16_t* O; int ldc; float scale;
    __device__ __forceinline__ void operator()(const f32x4 (&acc)[2][2][4][2], const Unit& u, int wr, int wc, int fr, int fq) const {
#pragma unroll
        for (int ai = 0; ai < 2; ++ai)
#pragma unroll
            for (int m = 0; m < 4; ++m) { const int grow = u.pm * 256 + ai * 128 + wr * 64 + m * 16 + fr;
#pragma unroll
                for (int bj = 0; bj < 2; ++bj) { const f32x4 v0 = acc[ai][bj][m][0] * scale, v1 = acc[ai][bj][m][1] * scale;
                    const int c8 = u.pn * 256 + bj * 128 + wc * 32 + fq * 8;
                    u32x4 w; w.x = cvtpk(v0[0], v0[1]); w.y = cvtpk(v0[2], v0[3]); w.z = cvtpk(v1[0], v1[1]); w.w = cvtpk(v1[2], v1[3]);
                    *(u32x4*)(O + (size_t)grow * ldc + c8) = w; } }
    }
};
template <bool SAMPLE> struct EpiUpConv {
    static constexpr bool PERM = true;
    bf16_t* H; const float* cw; const float* cb; const float* state; float* convp; float* convs;
    __device__ __forceinline__ void operator()(const f32x4 (&acc)[2][2][4][2], const Unit& u, int wr, int wc, int fr, int fq) const {
        const int lane = threadIdx.x & 63;
        const int src1 = (lane & 48) | ((lane - 1) & 15), src2 = (lane & 48) | ((lane - 2) & 15);
#pragma unroll
        for (int n = 0; n < 2; ++n) {
            const int gcol = u.pn * 128 + wc * 32 + fq * 8 + 4 * n;
            const f32x4 w0g = *(const f32x4*)(cw + gcol), w1g = *(const f32x4*)(cw + DFF2 + gcol), w2g = *(const f32x4*)(cw + 2 * DFF2 + gcol), bg = *(const f32x4*)(cb + gcol);
            const f32x4 w0v = *(const f32x4*)(cw + DFF + gcol), w1v = *(const f32x4*)(cw + DFF2 + DFF + gcol), w2v = *(const f32x4*)(cw + 2 * DFF2 + DFF + gcol), bv = *(const f32x4*)(cb + DFF + gcol);
#pragma unroll
            for (int ai = 0; ai < 2; ++ai)
#pragma unroll
                for (int m = 0; m < 4; ++m) {
                    const int lr = ai * 128 + wr * 64 + m * 16 + fr, rho = m * 16 + fr;
                    const f32x4 ug = acc[ai][0][m][n], uv = acc[ai][1][m][n];
                    const f32x4 pg = (m > 0) ? acc[ai][0][m - 1][n] : ug, pv = (m > 0) ? acc[ai][1][m - 1][n] : uv;
                    f32x4 t1g, t2g, t1v, t2v, p1g, p2g, p1v, p2v;
#pragma unroll
                    for (int j = 0; j < 4; ++j) { t1g[j] = (fr == 15) ? pg[j] : ug[j]; t2g[j] = (fr >= 14) ? pg[j] : ug[j]; t1v[j] = (fr == 15) ? pv[j] : uv[j]; t2v[j] = (fr >= 14) ? pv[j] : uv[j]; }
#pragma unroll
                    for (int j = 0; j < 4; ++j) { p1g[j] = __shfl(t1g[j], src1); p2g[j] = __shfl(t2g[j], src2); p1v[j] = __shfl(t1v[j], src1); p2v[j] = __shfl(t2v[j], src2); }
                    int grow; bool valid;
                    if (SAMPLE) {
                        grow = SEQ + lr; valid = true;
                        if ((m & 1) == 0) {
                            const int b = lr >> 5;
                            if (fr < 2) { const float* s0 = state + (size_t)(b * 2) * DFF2 + gcol; const float* s1 = s0 + DFF2;
                                const f32x4 s0g = *(const f32x4*)s0, s1g = *(const f32x4*)s1, s0v = *(const f32x4*)(s0 + DFF), s1v = *(const f32x4*)(s1 + DFF);
                                if (fr == 0) { p1g = s1g; p2g = s0g; p1v = s1v; p2v = s0v; } else { p2g = s1g; p2v = s1v; } }
                        }
                        const int t = lr & 31;
                        if (t >= 30) { float* cp = convs + (size_t)((lr >> 5) * 2 + (t - 30)) * DFF2 + gcol; *(f32x4*)cp = ug; *(f32x4*)(cp + DFF) = uv; }
                    } else {
                        grow = 62 * (4 * u.pm + 2 * ai + wr) + rho - 2; valid = (rho >= 2) && (grow < SEQ);
                        if (valid && grow >= SEQ - 2) { float* cp = convp + (size_t)(grow - (SEQ - 2)) * DFF2 + gcol; *(f32x4*)cp = ug; *(f32x4*)(cp + DFF) = uv; }
                    }
                    const f32x4 cg = w2g * ug + w1g * p1g + w0g * p2g + bg, cv = w2v * uv + w1v * p1v + w0v * p2v + bv;
                    f32x4 h;
#pragma unroll
                    for (int j = 0; j < 4; ++j) h[j] = cg[j] * __builtin_amdgcn_rcpf(1.f + __builtin_amdgcn_exp2f(-LOG2E * cg[j])) * cv[j];
                    if (valid) { u32x2 w; w.x = cvtpk(h[0], h[1]); w.y = cvtpk(h[2], h[3]); *(u32x2*)(H + (size_t)grow * DFF + gcol) = w; }
                }
        }
    }
};
}

__device__ __forceinline__ int crow(int r, int hi) { return (r & 3) + 8 * (r >> 2) + 4 * hi; }
typedef short v4i16_t __attribute__((ext_vector_type(4)));
__device__ __forceinline__ s16x4 vtr(const LAS unsigned char* p) { return __builtin_bit_cast(s16x4, __builtin_amdgcn_ds_read_tr16_b64_v4i16((LAS v4i16_t*)p)); }
template <int DQ, bool BIAS>
__device__ __forceinline__ void gsa_wave(const bf16_t* Q, int qp, const bf16_t* K, int kp, const bf16_t* V, int vp, int nkeys, const float* btab, int relbase,
                                         bf16_t* O, int op, LAS unsigned char* wl, int lane) {
    const int r32 = lane & 31, hi = lane >> 5;
    LAS float* wsf = (LAS float*)(wl + 4096);
    bf16x8 qr[DQ / 16];
#pragma unroll
    for (int d0 = 0; d0 < DQ / 16; ++d0) qr[d0] = *(const bf16x8*)(Q + (size_t)r32 * qp + d0 * 16 + hi * 8);
    f32x16 o0 = {}, o1 = {};
    float mrun = -INFINITY, l = 0.f;
    const LAS unsigned char* vb = wl + (4 * hi + ((lane & 15) >> 2)) * 64 + ((lane >> 4) & 1) * 32 + (lane & 3) * 8;
    for (int k0 = 0; k0 < nkeys; k0 += 32) {
        u32x4 vreg[4];
#pragma unroll
        for (int i = 0; i < 4; ++i) { const int idx = i * 64 + lane, key = idx >> 3, ch = idx & 7; vreg[i] = *(const u32x4*)(V + (size_t)(k0 + key) * vp + ch * 8); }
        f32x16 s = {};
#pragma unroll
        for (int d0 = 0; d0 < DQ / 16; ++d0) { const bf16x8 kf = *(const bf16x8*)(K + (size_t)(k0 + r32) * kp + d0 * 16 + hi * 8); s = __builtin_amdgcn_mfma_f32_32x32x16_bf16(kf, qr[d0], s, 0, 0, 0); }
#pragma unroll
        for (int i = 0; i < 4; ++i) { const int idx = i * 64 + lane, key = idx >> 3, ch = idx & 7; *(LAS u32x4*)(wl + ((ch >> 2) * 2 + (key >> 4)) * 1024 + (key & 15) * 64 + (ch & 3) * 16) = vreg[i]; }
        if (BIAS) {
#pragma unroll
            for (int r = 0; r < 16; ++r) s[r] += btab[relbase + r32 - (k0 + crow(r, hi))];
        }
        float mx = s[0];
#pragma unroll
        for (int r = 1; r < 16; ++r) mx = fmaxf(mx, s[r]);
        mx = fmaxf(mx, __shfl_xor(mx, 32));
        const float mnew = fmaxf(mrun, mx), alpha = __builtin_amdgcn_exp2f(mrun - mnew);
        float rs = 0.f;
#pragma unroll
        for (int r = 0; r < 16; ++r) { s[r] = __builtin_amdgcn_exp2f(s[r] - mnew); rs += s[r]; }
        rs += __shfl_xor(rs, 32);
        l = l * alpha + rs; mrun = mnew;
        if (hi == 0) wsf[r32] = alpha;
        asm volatile("s_waitcnt lgkmcnt(0)" ::: "memory");
#pragma unroll
        for (int g = 0; g < 4; ++g) { const f32x4 a4 = *(const LAS f32x4*)(wsf + 8 * g + 4 * hi);
#pragma unroll
            for (int j = 0; j < 4; ++j) { o0[4 * g + j] *= a4[j]; o1[4 * g + j] *= a4[j]; } }
        u32x4 pw0, pw1;
        pw0.x = cvtpk(s[0], s[1]); pw0.y = cvtpk(s[2], s[3]); pw0.z = cvtpk(s[4], s[5]); pw0.w = cvtpk(s[6], s[7]);
        pw1.x = cvtpk(s[8], s[9]); pw1.y = cvtpk(s[10], s[11]); pw1.z = cvtpk(s[12], s[13]); pw1.w = cvtpk(s[14], s[15]);
#pragma unroll
        for (int d0 = 0; d0 < 2; ++d0)
#pragma unroll
            for (int ks = 0; ks < 2; ++ks) {
                const s16x4 lo = vtr(vb + (d0 * 2 + ks) * 1024), hh = vtr(vb + (d0 * 2 + ks) * 1024 + 512);
                const bf16x8 vf = {lo[0], lo[1], lo[2], lo[3], hh[0], hh[1], hh[2], hh[3]};
                const bf16x8 pa = __builtin_bit_cast(bf16x8, ks == 0 ? pw0 : pw1);
                if (d0 == 0) o0 = __builtin_amdgcn_mfma_f32_32x32x16_bf16(pa, vf, o0, 0, 0, 0); else o1 = __builtin_amdgcn_mfma_f32_32x32x16_bf16(pa, vf, o1, 0, 0, 0);
            }
        asm volatile("s_waitcnt lgkmcnt(0)" ::: "memory");
    }
    if (hi == 0) wsf[r32] = 1.f / l;
    asm volatile("s_waitcnt lgkmcnt(0)" ::: "memory");
#pragma unroll
    for (int r = 0; r < 16; ++r) { const int q = crow(r, hi); const float rl = wsf[q];
        O[(size_t)q * op + r32] = f2bf(o0[r] * rl); O[(size_t)q * op + 32 + r32] = f2bf(o1[r] * rl); }
    asm volatile("s_waitcnt lgkmcnt(0)" ::: "memory");
}


namespace attn_body {
constexpr int NW = 8, QBLK = 32, QB = QBLK * NW, KVBLK = 64;
#define SBAR() __builtin_amdgcn_sched_barrier(0)
constexpr int NSLOT = 3, SLOTB = 8192;
constexpr int LDS_K = 0, LDS_V = NSLOT * SLOTB, LDS_WS = 2 * NSLOT * SLOTB, LDS_OST = LDS_WS + NW * 64 * 4, LDS_BYTES = LDS_OST + NW * 4096;
__device__ __forceinline__ void glds16(const void* gsrc, unsigned lds_dst) { unsigned keep;
  asm volatile("s_mov_b32 %0, m0\n\ts_mov_b32 m0, %2\n\ts_nop 0\n\tglobal_load_lds_dwordx4 %1, off\n\ts_mov_b32 m0, %0" : "=&s"(keep) : "v"(gsrc), "s"(lds_dst) : "memory"); }
__device__ __forceinline__ float max3f(float a, float b, float c) { float r; asm("v_max3_f32 %0, %1, %2, %3" : "=v"(r) : "v"(a), "v"(b), "v"(c)); return r; }
__device__ __forceinline__ float max2f(float a, float b) { float r; asm("v_max_f32_e32 %0, %1, %2" : "=v"(r) : "v"(a), "v"(b)); return r; }
__device__ __forceinline__ float fadd_s(float a, float b) { float r; asm("v_add_f32_e32 %0, %1, %2" : "=v"(r) : "v"(a), "v"(b)); return r; }
__device__ __forceinline__ float fsub_s(float a, float b) { float r; asm("v_sub_f32_e32 %0, %1, %2" : "=v"(r) : "v"(a), "v"(b)); return r; }
#define WAIT_BAR(N) asm volatile("s_waitcnt vmcnt(" #N ") lgkmcnt(0)\n\ts_barrier" ::: "memory")
__device__ __forceinline__ void qkt(f32x16& p0, f32x16& p1, const char* Kslot, const bf16x8* qr, const f32x16& negm, int r32, int hi) {
  const char* kb = Kslot + hi * 1024 + r32 * 16;
  #pragma unroll
  for (int d0 = 0; d0 < 4; ++d0) {
    const bf16x8 b0 = *reinterpret_cast<const bf16x8*>(kb + d0 * 2048);
    const bf16x8 b1 = *reinterpret_cast<const bf16x8*>(kb + d0 * 2048 + 512);
    if (d0 == 0) { p0 = __builtin_amdgcn_mfma_f32_32x32x16_bf16(b0, qr[0], negm, 0, 0, 0); p1 = __builtin_amdgcn_mfma_f32_32x32x16_bf16(b1, qr[0], negm, 0, 0, 0); }
    else { p0 = __builtin_amdgcn_mfma_f32_32x32x16_bf16(b0, qr[d0], p0, 0, 0, 0); p1 = __builtin_amdgcn_mfma_f32_32x32x16_bf16(b1, qr[d0], p1, 0, 0, 0); } }
}
typedef __attribute__((address_space(3))) const char* lds_cptr;
__device__ __forceinline__ void kload8(bf16x8* kf, lds_cptr kp) {
  kf[0] = *(const LAS bf16x8*)(kp);        kf[1] = *(const LAS bf16x8*)(kp + 512);
  kf[2] = *(const LAS bf16x8*)(kp + 2048); kf[3] = *(const LAS bf16x8*)(kp + 2560);
  kf[4] = *(const LAS bf16x8*)(kp + 4096); kf[5] = *(const LAS bf16x8*)(kp + 4608);
  kf[6] = *(const LAS bf16x8*)(kp + 6144); kf[7] = *(const LAS bf16x8*)(kp + 6656);
}
__device__ __forceinline__ void kload2(bf16x8* kf, lds_cptr kp, int j) { kf[2 * j] = *(const LAS bf16x8*)(kp + j * 2048); kf[2 * j + 1] = *(const LAS bf16x8*)(kp + j * 2048 + 512); }
__device__ __forceinline__ s16x4 vtr(lds_cptr p) { return __builtin_bit_cast(s16x4, __builtin_amdgcn_ds_read_tr16_b64_v4i16((LAS v4i16_t*)p)); }
__device__ __forceinline__ float rowmax(const f32x16& p0, const f32x16& p1) {
  float a = max3f(p0[0], p0[1], p1[0]), b = max3f(p0[2], p0[3], p1[1]); a = max3f(a, p1[2], p1[3]);
  #pragma unroll
  for (int r = 4; r < 16; r += 4) { a = max3f(a, p0[r], p0[r + 1]); b = max3f(b, p0[r + 2], p0[r + 3]); a = max3f(a, p1[r], p1[r + 1]); b = max3f(b, p1[r + 2], p1[r + 3]); }
  const float m = max2f(a, b);
  auto rr = __builtin_amdgcn_permlane32_swap(__float_as_uint(m), __float_as_uint(m), false, false);
  return max2f(__uint_as_float(rr[0]), __uint_as_float(rr[1]));
}
__device__ __forceinline__ void pv(f32x16* o, int vb, bf16x8 pa0, bf16x8 pa1, bf16x8 pa2, bf16x8 pa3) {
  #pragma unroll
  for (int d0 = 0; d0 < 2; ++d0) { s16x4 lo[4], hi[4];
    #pragma unroll
    for (int ks = 0; ks < 4; ++ks) {
      asm volatile("ds_read_b64_tr_b16 %0,%1 offset:%c2" : "=&v"(lo[ks]) : "v"(vb), "i"(d0 * 4096 + ks * 1024) : "memory");
      asm volatile("ds_read_b64_tr_b16 %0,%1 offset:%c2" : "=&v"(hi[ks]) : "v"(vb), "i"(d0 * 4096 + ks * 1024 + 512) : "memory"); }
    asm volatile("s_waitcnt lgkmcnt(0)" ::: "memory"); SBAR();
    #define PK(k) (bf16x8){lo[k][0], lo[k][1], lo[k][2], lo[k][3], hi[k][0], hi[k][1], hi[k][2], hi[k][3]}
    o[d0] = __builtin_amdgcn_mfma_f32_32x32x16_bf16(pa0, PK(0), o[d0], 0, 0, 0);
    o[d0] = __builtin_amdgcn_mfma_f32_32x32x16_bf16(pa1, PK(1), o[d0], 0, 0, 0);
    o[d0] = __builtin_amdgcn_mfma_f32_32x32x16_bf16(pa2, PK(2), o[d0], 0, 0, 0);
    o[d0] = __builtin_amdgcn_mfma_f32_32x32x16_bf16(pa3, PK(3), o[d0], 0, 0, 0);
    #undef PK
  }
}
template <int THRL> __device__ __forceinline__ void attn_unit(int qb, const bf16_t* Qh, const bf16_t* __restrict__ Kh, const bf16_t* __restrict__ Vh, const int PQ, bf16_t* Oh, const int PO, char* shm) {
  const int tid = threadIdx.x, lane = tid & 63, r32 = lane & 31, hi = lane >> 5; const int wid = __builtin_amdgcn_readfirstlane(tid >> 6);
  const int q0 = qb * QB;
  const bf16_t* Qw = Qh + (long)(q0 + wid * QBLK) * PQ;
  const unsigned lds0 = (unsigned)(uintptr_t)shm;
  float* wsf = (float*)(shm + LDS_WS) + wid * 64;
  const bf16_t* ksrc = Kh + (long)lane * PQ + wid * 8;
  const bf16_t* vsrc = Vh + (long)(16 * (wid & 3) + (lane >> 2)) * PQ + (wid >> 2) * 32 + (lane & 3) * 8;
  const unsigned kdst = lds0 + LDS_K + wid * 1024, vdst = lds0 + LDS_V + wid * 1024;
  #define DMA_K(t, slot) glds16(ksrc + (long)(t) * KVBLK * PQ, (unsigned)__builtin_amdgcn_readfirstlane(kdst + (slot)))
  #define DMA_V(t, slot) glds16(vsrc + (long)(t) * KVBLK * PQ, (unsigned)__builtin_amdgcn_readfirstlane(vdst + (slot)))
  const int vb0 = (int)(lds0 + LDS_V) + ((lane >> 4) & 1) * 32 + (lane & 3) * 8 + (4 * hi + ((lane & 15) >> 2)) * 64;
  const char* Kbase = shm + LDS_K; bf16x8 kf[8];
  const lds_cptr shm3 = (lds_cptr)shm; const lds_cptr kp0 = shm3 + LDS_K + hi * 1024 + r32 * 16; const lds_cptr vp0 = shm3 + LDS_V + ((lane >> 4) & 1) * 32 + (lane & 3) * 8 + (4 * hi + ((lane & 15) >> 2)) * 64;
  const int NT = (q0 + QB) / KVBLK;
  DMA_K(0, 0); DMA_V(0, 0); DMA_K(1, SLOTB);
  bf16x8 qr[4];
  #pragma unroll
  for (int d0 = 0; d0 < 4; ++d0) qr[d0] = *reinterpret_cast<const bf16x8*>(&Qw[(long)r32 * PQ + d0 * 16 + hi * 8]);
  float mhat = 0.f, l_reg = 0.f; f32x16 o[2]; o[0] = f32x16{}; o[1] = f32x16{}; f32x16 negm = f32x16{}; asm volatile("" : "+v"(negm));
  const int wchunk = wid >> 1;
  #define CMASK(P0, P1, t) do { int jb_ = (t) - (NT - 4); if (jb_ > wchunk) { _Pragma("unroll") for (int r_ = 0; r_ < 16; ++r_) { P0[r_] = -INFINITY; P1[r_] = -INFINITY; } } } while (0)
  bool resc = false;
  #define START(P0, P1) do { const float rm = rowmax(P0, P1); resc = false; \
    { const float dl = rm; mhat = fadd_s(mhat, dl); \
      _Pragma("unroll") for (int r = 0; r < 16; ++r) { P0[r] = fsub_s(P0[r], dl); P1[r] = fsub_s(P1[r], dl); } \
      _Pragma("unroll") for (int r = 0; r < 16; ++r) negm[r] = -mhat; asm volatile("" : "+v"(negm)); } \
    _Pragma("unroll") for (int r = 0; r < 16; ++r) P0[r] = __builtin_amdgcn_exp2f(P0[r]); } while (0)
  #define RESC() do { if (resc) { asm volatile("s_waitcnt lgkmcnt(0)" ::: "memory"); \
      _Pragma("unroll") for (int d_ = 0; d_ < 2; ++d_) _Pragma("unroll") for (int r = 0; r < 16; ++r) o[d_][r] *= wsf[crow(r, hi)]; } } while (0)
  f32x16 pA0, pA1, pB0, pB1;
  int sl_prev = 0, sl_cur = 0, sl_next = SLOTB;
  #define ROT() do { sl_prev = sl_cur; sl_cur = sl_next; sl_next = (sl_next == (NSLOT - 1) * SLOTB) ? 0 : sl_next + SLOTB; } while (0)
  DMA_K(2, 2 * SLOTB);
  WAIT_BAR(3);
  qkt(pA0, pA1, Kbase, qr, negm, r32, hi); asm volatile("s_nop 15\n\ts_nop 7" : "+v"(pA0), "+v"(pA1)); CMASK(pA0, pA1, 0);
  START(pA0, pA1);
  _Pragma("unroll") for (int r = 0; r < 16; ++r) pA1[r] = __builtin_amdgcn_exp2f(pA1[r]);
  WAIT_BAR(0);
  DMA_K(3, 0); DMA_V(1, SLOTB);
  ROT();
  kload8(kf, kp0 + sl_cur);
  WAIT_BAR(2);
  s16x4 vlo[8], vhi[8]; u32x4 pw0, pw1, pw2, pw3;
  #define PKW(P, B) cvtpk(P[B], P[B + 1])
  #define PAF(k) __builtin_bit_cast(bf16x8, pw##k)
  #define VFR(i) (bf16x8){vlo[i][0], vlo[i][1], vlo[i][2], vlo[i][3], vhi[i][0], vhi[i][1], vhi[i][2], vhi[i][3]}
  #define PIN(x) asm volatile("" : "+v"(x))
  #define MX3(a, b, c) __builtin_fmaxf(__builtin_fmaxf((a), (b)), (c))
  #define GAPA(MF, A0, A1, A2, A3, W0, W1, PW) do { MF; sacc += A0; sacc += A1; sacc += A2; sacc += A3; PIN(sacc); W0; W1; PIN(PW); SBAR(); } while (0)
  #define EX(v) __builtin_amdgcn_exp2f(v)
  #define GAPB(MF, X, B) do { MF; X[B] = EX(X[B]); X[B + 1] = EX(X[B + 1]); X[B + 2] = EX(X[B + 2]); X[B + 3] = EX(X[B + 3]); PIN(X); SBAR(); } while (0)
  #define VRD(i) do { vlo[i] = vtr(vp_ + (((i) >> 2) * 4096 + ((i) & 3) * 1024)); vhi[i] = vtr(vp_ + (((i) >> 2) * 4096 + ((i) & 3) * 1024 + 512)); } while (0)
  #define KRD(G, j) do { if (G) { kload2(kf, kp0 + sl_next, j); SBAR(); } } while (0)
  #define STEP(C0, C1, P0, P1, t, GK, GV, GL) do { SBAR(); \
    const lds_cptr vp_ = vp0 + sl_prev; \
    VRD(0); SBAR(); float sacc = (P0[0] + P0[1]); \
    GAPA(C0 = __builtin_amdgcn_mfma_f32_32x32x16_bf16(kf[0], qr[0], negm, 0, 0, 0), P0[2], P0[3], P0[4], P0[5],     pw0[0] = PKW(P0, 0), pw0[1] = PKW(P0, 2), pw0); \
    VRD(4); SBAR(); GAPA(C1 = __builtin_amdgcn_mfma_f32_32x32x16_bf16(kf[1], qr[0], negm, 0, 0, 0), P0[6], P0[7], P0[8], P0[9],     pw0[2] = PKW(P0, 4), pw0[3] = PKW(P0, 6), pw0); \
    VRD(1); SBAR(); GAPA(C0 = __builtin_amdgcn_mfma_f32_32x32x16_bf16(kf[2], qr[1], C0, 0, 0, 0),   P0[10], P0[11], P0[12], P0[13], pw1[0] = PKW(P0, 8), pw1[1] = PKW(P0, 10), pw1); \
    VRD(5); SBAR(); GAPA(C1 = __builtin_amdgcn_mfma_f32_32x32x16_bf16(kf[3], qr[1], C1, 0, 0, 0),   P0[14], P0[15], P1[0], P1[1],   pw1[2] = PKW(P0, 12), pw1[3] = PKW(P0, 14), pw1); \
    VRD(2); SBAR(); GAPA(C0 = __builtin_amdgcn_mfma_f32_32x32x16_bf16(kf[4], qr[2], C0, 0, 0, 0),   P1[2], P1[3], P1[4], P1[5],     pw2[0] = PKW(P1, 0), pw2[1] = PKW(P1, 2), pw2); \
    VRD(6); SBAR(); GAPA(C1 = __builtin_amdgcn_mfma_f32_32x32x16_bf16(kf[5], qr[2], C1, 0, 0, 0),   P1[6], P1[7], P1[8], P1[9],     pw2[2] = PKW(P1, 4), pw2[3] = PKW(P1, 6), pw2); \
    VRD(3); SBAR(); GAPA(C0 = __builtin_amdgcn_mfma_f32_32x32x16_bf16(kf[6], qr[3], C0, 0, 0, 0),   P1[10], P1[11], P1[12], P1[13], pw3[0] = PKW(P1, 8), pw3[1] = PKW(P1, 10), pw3); \
    VRD(7); SBAR(); GAPA(C1 = __builtin_amdgcn_mfma_f32_32x32x16_bf16(kf[7], qr[3], C1, 0, 0, 0),   P1[14], P1[15], 0.f, 0.f,       pw3[2] = PKW(P1, 12), pw3[3] = PKW(P1, 14), pw3); \
    l_reg += sacc; \
    if (GK) { DMA_K((t) + 3, sl_cur); } if (GV) { DMA_V((t) + 1, sl_next); } \
    CMASK(C0, C1, t); \
    { float a = MX3(C0[0], C0[1], C1[0]), b = MX3(C0[2], C0[3], C1[1]); a = MX3(a, C1[2], C1[3]); \
      _Pragma("unroll") for (int r = 4; r < 16; r += 4) { a = MX3(a, C0[r], C0[r + 1]); b = MX3(b, C0[r + 2], C0[r + 3]); a = MX3(a, C1[r], C1[r + 1]); b = MX3(b, C1[r + 2], C1[r + 3]); } \
      float rm = __builtin_fmaxf(a, b); { auto rr = __builtin_amdgcn_permlane32_swap(__float_as_uint(rm), __float_as_uint(rm), false, false); rm = __builtin_fmaxf(__uint_as_float(rr[0]), __uint_as_float(rr[1])); } \
      resc = false; \
      if (__builtin_expect(__any(rm > (float)THRL), 0)) { const float dl = __builtin_fmaxf(rm, 0.f); mhat += dl; \
        _Pragma("unroll") for (int r = 0; r < 16; ++r) { C0[r] -= dl; C1[r] -= dl; } \
        _Pragma("unroll") for (int r = 0; r < 16; ++r) negm[r] = -mhat; asm volatile("" : "+v"(negm)); \
        const float f = __builtin_amdgcn_exp2f(-dl); l_reg *= f; if (hi == 0) wsf[r32] = f; resc = true; } } \
    SBAR(); \
    GAPB(o[0] = __builtin_amdgcn_mfma_f32_32x32x16_bf16(PAF(0), VFR(0), o[0], 0, 0, 0), C0, 0); \
    GAPB(o[1] = __builtin_amdgcn_mfma_f32_32x32x16_bf16(PAF(0), VFR(4), o[1], 0, 0, 0), C0, 4); \
    KRD(GL, 0); GAPB(o[0] = __builtin_amdgcn_mfma_f32_32x32x16_bf16(PAF(1), VFR(1), o[0], 0, 0, 0), C0, 8); \
    KRD(GL, 1); GAPB(o[1] = __builtin_amdgcn_mfma_f32_32x32x16_bf16(PAF(1), VFR(5), o[1], 0, 0, 0), C0, 12); \
    KRD(GL, 2); GAPB(o[0] = __builtin_amdgcn_mfma_f32_32x32x16_bf16(PAF(2), VFR(2), o[0], 0, 0, 0), C1, 0); \
    KRD(GL, 3); GAPB(o[1] = __builtin_amdgcn_mfma_f32_32x32x16_bf16(PAF(2), VFR(6), o[1], 0, 0, 0), C1, 4); \
    GAPB(o[0] = __builtin_amdgcn_mfma_f32_32x32x16_bf16(PAF(3), VFR(3), o[0], 0, 0, 0), C1, 8); \
    GAPB(o[1] = __builtin_amdgcn_mfma_f32_32x32x16_bf16(PAF(3), VFR(7), o[1], 0, 0, 0), C1, 12); \
    } while (0)
  int t = 1;
  #undef CMASK
  #define CMASK(P0, P1, t) do {} while (0)
  for (; t + 5 < NT; t += 2) {
    STEP(pB0, pB1, pA0, pA1, t, true, true, true);     WAIT_BAR(2); RESC(); ROT();
    STEP(pA0, pA1, pB0, pB1, t + 1, true, true, true); WAIT_BAR(2); RESC(); ROT();
  }
  #undef CMASK
  #define CMASK(P0, P1, t) do { int jb_ = (t) - (NT - 4); if (jb_ > wchunk) { _Pragma("unroll") for (int r_ = 0; r_ < 16; ++r_) { P0[r_] = -INFINITY; P1[r_] = -INFINITY; } } } while (0)
  #define ENDW(tt) do { if ((tt) + 3 < NT) { WAIT_BAR(2); } else if ((tt) + 2 < NT) { WAIT_BAR(1); } else { WAIT_BAR(0); } } while (0)
  for (; t + 1 < NT; t += 2) {
    STEP(pB0, pB1, pA0, pA1, t, (t + 3 < NT), (t + 1 < NT), (t + 1 < NT));         ENDW(t);     RESC(); ROT();
    STEP(pA0, pA1, pB0, pB1, t + 1, (t + 4 < NT), (t + 2 < NT), (t + 2 < NT));     ENDW(t + 1); RESC(); ROT();
  }
  STEP(pB0, pB1, pA0, pA1, NT - 1, false, false, false); RESC();
  { float sacc = pB0[0] + pB0[1]; _Pragma("unroll") for (int r = 2; r < 16; ++r) sacc += pB0[r]; _Pragma("unroll") for (int r = 0; r < 16; ++r) sacc += pB1[r]; l_reg += sacc;
    pw0 = (u32x4){PKW(pB0, 0), PKW(pB0, 2), PKW(pB0, 4), PKW(pB0, 6)}; pw1 = (u32x4){PKW(pB0, 8), PKW(pB0, 10), PKW(pB0, 12), PKW(pB0, 14)}; pw2 = (u32x4){PKW(pB1, 0), PKW(pB1, 2), PKW(pB1, 4), PKW(pB1, 6)}; pw3 = (u32x4){PKW(pB1, 8), PKW(pB1, 10), PKW(pB1, 12), PKW(pB1, 14)};
    SBAR(); pv(o, vb0 + sl_cur, PAF(0), PAF(1), PAF(2), PAF(3)); }
  #undef PKW
  #undef PAF
  #undef VFR
  #undef PIN
  #undef MX3
  #undef GAPA
  #undef GAPB
  #undef EX
  #undef VRD
  #undef KRD
  #undef STEP
  #undef ENDW
  { auto rr = __builtin_amdgcn_permlane32_swap(__float_as_uint(l_reg), __float_as_uint(l_reg), false, false); l_reg = __uint_as_float(rr[0]) + __uint_as_float(rr[1]); }
  if (hi == 0) wsf[32 + r32] = l_reg; asm volatile("s_waitcnt lgkmcnt(0)" ::: "memory");
  float rli[16];
  #pragma unroll
  for (int r = 0; r < 16; ++r) rli[r] = __builtin_amdgcn_rcpf(wsf[32 + crow(r, hi)]);
  bf16_t* Ow = Oh + (long)(q0 + wid * QBLK) * PO;
  { bf16_t* stg = (bf16_t*)(shm + LDS_OST) + wid * 2048;
    #pragma unroll
    for (int r = 0; r < 16; ++r) { const int orow = crow(r, hi);
      #pragma unroll
      for (int d0 = 0; d0 < 2; ++d0) stg[orow * 64 + d0 * 32 + r32] = f2bf(o[d0][r] * rli[r]); }
    asm volatile("s_waitcnt lgkmcnt(0)" ::: "memory");
    #pragma unroll
    for (int i = 0; i < 4; ++i) { const int row = i * 8 + (lane >> 3), ch = lane & 7; const u32x4 v = *(const u32x4*)(stg + row * 64 + ch * 8); *(u32x4*)(Ow + (long)row * PO + ch * 8) = v; } }
  asm volatile("s_waitcnt lgkmcnt(0)\n\ts_barrier" ::: "memory");
  #undef DMA_K
  #undef DMA_V
  #undef CMASK
  #undef START
  #undef RESC
  #undef ROT
}
#undef SBAR
#undef WAIT_BAR
}

typedef GAS unsigned gu32;
#define RLX_AGENT __ATOMIC_RELAXED, __HIP_MEMORY_SCOPE_AGENT
#define XB_TMO      128
#define XB_XCNT(j)  (256  + 64 * (j))
#define XB_XSUB(j)  (1280 + 64 * (j))
#define XB_XGEN(j)  (2304 + 64 * (j))
#define XB_TOP      3328
#define XB_TOPGEN   3392
#define XCD_BAR_WORDS 3456
#define XB_SPIN_CAP (1u << 18)
__device__ __forceinline__ unsigned xb_ld(unsigned* p)              { return __hip_atomic_load(p, __ATOMIC_RELAXED, __HIP_MEMORY_SCOPE_AGENT); }
__device__ __forceinline__ unsigned xb_add(unsigned* p, unsigned v) { return __hip_atomic_fetch_add(p, v, __ATOMIC_RELAXED, __HIP_MEMORY_SCOPE_AGENT); }
__device__ __forceinline__ unsigned xb_xcc_id() { return (unsigned)__builtin_amdgcn_s_getreg((3 << 11) | 20) & 0xFu; }
#define XB_SPIN(cond, bar) do { unsigned _sp = 0; while (cond) { __builtin_amdgcn_s_sleep(1); \
    if ((++_sp & 255u) == 0u) { if (xb_ld(&(bar)[XB_TMO])) break; if (_sp > XB_SPIN_CAP) { atomicAdd(&(bar)[XB_TMO], 1u); break; } } } } while (0)
struct XcdBarrier { unsigned* bar; unsigned x; volatile LAS unsigned* st; };
__device__ __forceinline__ XcdBarrier xcd_barrier_post(unsigned* bar, volatile LAS unsigned* st) {
    XcdBarrier b; b.bar = bar; b.x = xb_xcc_id(); b.st = st;
    if (threadIdx.x == 0) (void)xb_add(&bar[XB_XCNT(b.x)], 1u);
    return b;
}
__device__ __forceinline__ void xcd_barrier_complete(unsigned* bar, unsigned x, unsigned& nloc, unsigned& nx) {
    const unsigned G = gridDim.x * gridDim.y * gridDim.z;
    unsigned sum, cnt, mine, sp = 0u;
    for (;;) {
        sum = 0u; cnt = 0u; mine = 0u;
#pragma unroll
        for (unsigned j = 0; j < 16; ++j) { const unsigned c = xb_ld(&bar[XB_XCNT(j)]); sum += c; cnt += (c > 0u) ? 1u : 0u; mine = (j == x) ? c : mine; }
        if (sum == G) break;
        __builtin_amdgcn_s_sleep(1);
        if ((++sp & 255u) == 0u) { if (xb_ld(&bar[XB_TMO])) break; if (sp > XB_SPIN_CAP) { atomicAdd(&bar[XB_TMO], 1u); break; } }
    }
    nloc = mine > 0u ? mine : 1u; nx = cnt > 0u ? cnt : 1u;
}
__device__ __forceinline__ void xcd_barrier(const XcdBarrier& b) {
    asm volatile("s_waitcnt vmcnt(0)" ::: "memory");
    __syncthreads();
    if (threadIdx.x == 0) {
        unsigned* bar = b.bar;
        __builtin_amdgcn_s_waitcnt(0);
        unsigned nloc = b.st[0], nx = b.st[1];
        if (nloc == 0u) { xcd_barrier_complete(bar, b.x, nloc, nx); b.st[0] = nloc; b.st[1] = nx; }
        const unsigned old = xb_add(&bar[XB_XSUB(b.x)], 1u);
        const unsigned gen = old / nloc;
        if (old + 1u == (gen + 1u) * nloc) {
            __builtin_amdgcn_fence(__ATOMIC_RELEASE, "agent");
            asm volatile("s_waitcnt vmcnt(0)" ::: "memory");
            const unsigned og = xb_add(&bar[XB_TOP], 1u);
            const unsigned tg = og / nx;
            if (og + 1u == (tg + 1u) * nx) xb_add(&bar[XB_TOPGEN], 1u);
            else XB_SPIN(xb_ld(&bar[XB_TOPGEN]) == tg, bar);
            __builtin_amdgcn_fence(__ATOMIC_ACQUIRE, "agent");
            xb_add(&bar[XB_XGEN(b.x)], 1u);
            asm volatile("s_waitcnt vmcnt(0)" ::: "memory");
        } else {
            XB_SPIN(xb_ld(&bar[XB_XGEN(b.x)]) == gen, bar);
            __builtin_amdgcn_fence(__ATOMIC_ACQUIRE, "agent");
            asm volatile("s_waitcnt vmcnt(0)" ::: "memory");
        }
    }
    __syncthreads();
}

__device__ __forceinline__ void team_barrier(unsigned* cnt, unsigned target) {
    asm volatile("s_waitcnt vmcnt(0)" ::: "memory");
    __syncthreads();
    if (threadIdx.x == 0) {
        __builtin_amdgcn_fence(__ATOMIC_RELEASE, "agent");
        asm volatile("s_waitcnt vmcnt(0)" ::: "memory");
        xb_add(cnt, 1u);
        unsigned sp = 0;
        while (xb_ld(cnt) < target) { __builtin_amdgcn_s_sleep(2); if (++sp > (1u << 22)) break; }
        __builtin_amdgcn_fence(__ATOMIC_ACQUIRE, "agent");
        asm volatile("s_waitcnt vmcnt(0)" ::: "memory");
    }
    __syncthreads();
}

constexpr int NWAVES = 8;
constexpr int RING_BYTES = 131072, LDSCTL_OFF = RING_BYTES, MISC_OFF = LDSCTL_OFF + 320, LDS_BYTES = 147456;
constexpr int CW_BAR = 4096;
constexpr int NPHASE = 13;
#ifndef MK_N_LAUNCHES
#define MK_N_LAUNCHES 1
#endif
#ifndef PROBE_DUP
#define PROBE_DUP -1
#endif
#define REP(k) for (int rep_ = 0; rep_ < 1 + (PROBE_DUP == (k) ? 1 : 0); ++rep_)
constexpr int N_LAUNCHES = MK_N_LAUNCHES;

#define LDS_WAIT() asm volatile("s_waitcnt lgkmcnt(0)" ::: "memory")
__device__ __forceinline__ float wave_sum(float v) {
#pragma unroll
    for (int o = 1; o < 64; o <<= 1) v += __shfl_xor(v, o);
    return v;
}
__device__ __forceinline__ void p0_transpose_item(const float* W, int K, int N, bf16_t* WT, int k0, int n0, int orow0, LAS float* scr, int lane) {
#pragma unroll 8
    for (int i = 0; i < 32; ++i) { const int kk = 2 * i + (lane >> 5); scr[kk * 33 + (lane & 31)] = W[(size_t)(k0 + kk) * N + n0 + (lane & 31)]; }
    LDS_WAIT(); asm volatile("" ::: "memory");
    const int c = lane & 7;
#pragma unroll
    for (int j = 0; j < 4; ++j) { const int n = (lane >> 3) + 8 * j; const LAS float* s = scr + (8 * c) * 33 + n;
        u32x4 o; o.x = cvtpk(s[0 * 33], s[1 * 33]); o.y = cvtpk(s[2 * 33], s[3 * 33]); o.z = cvtpk(s[4 * 33], s[5 * 33]); o.w = cvtpk(s[6 * 33], s[7 * 33]);
        *(u32x4*)(WT + (size_t)(orow0 + n) * K + k0 + 8 * c) = o; }
    LDS_WAIT(); asm volatile("" ::: "memory");
}
__device__ __forceinline__ void sincos_d(double a, double& s, double& c) {
    const double k = __builtin_rint(a * 0.63661977236758134308);
    double r = __builtin_fma(-k, 1.57079632679489655800e+00, a); r = __builtin_fma(-k, 6.12323399573676603587e-17, r);
    const double r2 = r * r;
    double sp = -7.6471637318198164759e-13; sp = sp * r2 + 1.6059043836821614599e-10; sp = sp * r2 - 2.5052108385441718775e-08; sp = sp * r2 + 2.7557319223985890653e-06;
    sp = sp * r2 - 1.9841269841269841270e-04; sp = sp * r2 + 8.3333333333333333333e-03; sp = sp * r2 - 1.6666666666666666667e-01; const double sr = r + r * r2 * sp;
    double cp = 4.7794773323873852974e-14; cp = cp * r2 - 1.1470745597729724714e-11; cp = cp * r2 + 2.0876756987868098979e-09; cp = cp * r2 - 2.7557319223985890653e-07;
    cp = cp * r2 + 2.4801587301587301587e-05; cp = cp * r2 - 1.3888888888888888889e-03; cp = cp * r2 + 4.1666666666666666667e-02; cp = cp * r2 - 0.5; const double cr = 1.0 + r2 * cp;
    const int q = ((int)k) & 3;
    s = (q == 0) ? sr : (q == 1) ? cr : (q == 2) ? -sr : -cr;
    c = (q == 0) ? cr : (q == 1) ? -sr : (q == 2) ? -cr : sr;
}

struct Args { const float* in[32]; float* out; unsigned char* ws; int ph_lo, ph_hi, li, pad; };

__global__ void __launch_bounds__(NWAVES * 64, 2) mk_fwd(Args args) {
    extern __shared__ __attribute__((aligned(16))) unsigned char lds_raw[];
    LAS unsigned char* lds = (LAS unsigned char*)lds_raw;
    volatile LAS unsigned* MISC = (volatile LAS unsigned*)(lds + MISC_OFF);
    const int wave = __builtin_amdgcn_readfirstlane(threadIdx.x >> 6);
#define PHASE_IDS() int tid = threadIdx.x; asm volatile("" : "+v"(tid)); const int lane = tid & 63; (void)lane
    const int G = gridDim.x, bx = blockIdx.x;
    const int gw = bx * NWAVES + wave, NGW = G * NWAVES;
    unsigned char* ws = args.ws; float* out = args.out;
    gu32* ctl = (gu32*)(ws + WS_CTL);
    for (int u = threadIdx.x; u < (LDS_BYTES - LDSCTL_OFF) / 4; u += NWAVES * 64) ((LAS unsigned*)(lds + LDSCTL_OFF))[u] = 0u;
    __syncthreads();
    XcdBarrier bar; bar.bar = (unsigned*)(ctl + CW_BAR); bar.x = 0; bar.st = nullptr;
    if (N_LAUNCHES == 1) bar = xcd_barrier_post((unsigned*)(ctl + CW_BAR), MISC + 8);
#define GRID_BAR() do { if (N_LAUNCHES == 1) xcd_barrier(bar); } while (0)
    const int lo = args.ph_lo, hi_ph = args.ph_hi;
#define IN(k) (lo <= (k) && (k) < hi_ph)
#define SEAM(k) do { if (IN(k) && IN((k) + 1)) GRID_BAR(); } while (0)

    const float* x_prompt = args.in[0]; const float* x_sample = args.in[1]; const float* mem_prompt = args.in[2];
#define Wqkv_t ((bf16_t*)(ws + WS_WQKV))
#define Wo_t ((bf16_t*)(ws + WS_WO))
#define Wmq_t ((bf16_t*)(ws + WS_WMQ))
#define Wmkv_t ((bf16_t*)(ws + WS_WMKV))
#define Wmo_t ((bf16_t*)(ws + WS_WMO))
#define Wup_t ((bf16_t*)(ws + WS_WUP))
#define Wdn_t ((bf16_t*)(ws + WS_WDN))
#define MEMB ((bf16_t*)(ws + WS_MEMB))
#define MKB ((bf16_t*)(ws + WS_MKB))
#define MVB ((bf16_t*)(ws + WS_MVB))
#define KAS ((bf16_t*)(ws + WS_KAS))
#define VAS ((bf16_t*)(ws + WS_VAS))
#define KBS ((bf16_t*)(ws + WS_KBS))
#define VBS ((bf16_t*)(ws + WS_VBS))
#define MKS ((bf16_t*)(ws + WS_MKS))
#define MVS ((bf16_t*)(ws + WS_MVS))
#define QKVB ((bf16_t*)(ws + WS_QKVB))
#define XB ((bf16_t*)(ws + WS_XB))
#define OD ((bf16_t*)(ws + WS_OD))
#define MIXA ((bf16_t*)(ws + WS_MIXA))
#define X1B ((bf16_t*)(ws + WS_X1B))
#define X2B ((bf16_t*)(ws + WS_X2B))
#define QM ((bf16_t*)(ws + WS_QM))
#define OM ((bf16_t*)(ws + WS_OM))
#define HB ((bf16_t*)(ws + WS_H))
#define ROPE ((float*)(ws + WS_ROPE))
#define BT ((float*)(ws + WS_BT))
#define LAMP ((float*)(ws + WS_LAM))
    float* R = out + OFF_Y;

#define LN_PASS(gp, bp, XO, r0, r1, w_, nw_) do { \
        for (int m = (r0) + (w_); m < (r1); m += (nw_)) { \
            f32x4* xr = (f32x4*)(R + (size_t)m * DM) + lane; f32x4 v[4]; float s = 0.f; \
            _Pragma("unroll") for (int j = 0; j < 4; ++j) { v[j] = xr[64 * j]; s += (v[j][0] + v[j][1]) + (v[j][2] + v[j][3]); } \
            const float mean = wave_sum(s) * (1.f / DM); float s2 = 0.f; \
            _Pragma("unroll") for (int j = 0; j < 4; ++j) { v[j] = v[j] - mean; s2 += (v[j][0] * v[j][0] + v[j][1] * v[j][1]) + (v[j][2] * v[j][2] + v[j][3] * v[j][3]); } \
            const float rstd = 1.f / sqrtf(wave_sum(s2) * (1.f / DM) + LN_EPS); \
            _Pragma("unroll") for (int j = 0; j < 4; ++j) { const f32x4 gg = *((const f32x4*)(gp) + lane + 64 * j), bb = *((const f32x4*)(bp) + lane + 64 * j); \
                const f32x4 y = v[j] * rstd * gg + bb; xr[64 * j] = y; \
                if (XO) { u32x2 w; w.x = cvtpk(y[0], y[1]); w.y = cvtpk(y[2], y[3]); *((u32x2*)((bf16_t*)(XO) + (size_t)m * DM) + lane + 64 * j) = w; } } \
        } } while (0)
#define COMBINE_ROWS(ODp, MXp, r0, r1, w_, nw_) do { \
        const float lam = LAMP[0]; const int h = lane >> 4, d0 = (lane & 15) * 8; \
        const f32x4 g0 = *(const f32x4*)(args.in[16] + d0), g1 = *(const f32x4*)(args.in[16] + d0 + 4); \
        for (int m = (r0) + (w_); m < (r1); m += (nw_)) { \
            const u32x4 a = *(const u32x4*)((ODp) + (size_t)m * DM + h * 256 + d0), b = *(const u32x4*)((ODp) + (size_t)m * DM + h * 256 + 128 + d0); \
            float o[8]; float ss = 0.f; \
            _Pragma("unroll") for (int j = 0; j < 4; ++j) { const unsigned ua = a[j], ub = b[j]; \
                o[2 * j] = __uint_as_float(ua << 16) - lam * __uint_as_float(ub << 16); o[2 * j + 1] = __uint_as_float(ua & 0xffff0000u) - lam * __uint_as_float(ub & 0xffff0000u); \
                ss += o[2 * j] * o[2 * j] + o[2 * j + 1] * o[2 * j + 1]; } \
            ss += __shfl_xor(ss, 1); ss += __shfl_xor(ss, 2); ss += __shfl_xor(ss, 4); ss += __shfl_xor(ss, 8); \
            const float rn = 0.8f / sqrtf(ss * (1.f / 128.f) + LN_EPS); \
            u32x4 w; w.x = cvtpk(o[0] * rn * g0[0], o[1] * rn * g0[1]); w.y = cvtpk(o[2] * rn * g0[2], o[3] * rn * g0[3]); w.z = cvtpk(o[4] * rn * g1[0], o[5] * rn * g1[1]); w.w = cvtpk(o[6] * rn * g1[2], o[7] * rn * g1[3]); \
            *(u32x4*)((MXp) + (size_t)m * DM + 512 + h * 128 + d0) = w; \
        } } while (0)
    if (IN(0)) REP(0) {
        PHASE_IDS();
        LAS float* scr = (LAS float*)(lds + wave * 16384);
        {
            constexpr int I_QKV = 16 * 96, I_SQ = 16 * 32, I_UP = 16 * 176, I_DN = 44 * 32;
            constexpr int NITEMS = I_QKV + 5 * I_SQ + I_UP + I_DN;
            for (int it = gw; it < NITEMS; it += NGW) {
                int r = it;
                if (r < I_QKV) { const int kb = r / 96, nb = r % 96; p0_transpose_item(args.in[10], 1024, 3072, Wqkv_t, kb * 64, nb * 32, nb * 32, scr, lane); continue; } r -= I_QKV;
                if (r < I_SQ) { const int kb = r / 32, nb = r % 32; p0_transpose_item(args.in[17], 1024, 1024, Wo_t, kb * 64, nb * 32, nb * 32, scr, lane); continue; } r -= I_SQ;
                if (r < I_SQ) { const int kb = r / 32, nb = r % 32; p0_transpose_item(args.in[20], 1024, 1024, Wmq_t, kb * 64, nb * 32, nb * 32, scr, lane); continue; } r -= I_SQ;
                if (r < I_SQ) { const int kb = r / 32, nb = r % 32; p0_transpose_item(args.in[21], 1024, 1024, Wmkv_t, kb * 64, nb * 32, nb * 32, scr, lane); continue; } r -= I_SQ;
                if (r < I_SQ) { const int kb = r / 32, nb = r % 32; p0_transpose_item(args.in[22], 1024, 1024, Wmkv_t, kb * 64, nb * 32, 1024 + nb * 32, scr, lane); continue; } r -= I_SQ;
                if (r < I_SQ) { const int kb = r / 32, nb = r % 32; p0_transpose_item(args.in[23], 1024, 1024, Wmo_t, kb * 64, nb * 32, nb * 32, scr, lane); continue; } r -= I_SQ;
                if (r < I_UP) { const int kb = r / 176, nb = r % 176, n0 = nb * 32, bj = n0 / DFF, f = n0 % DFF; p0_transpose_item(args.in[26], 1024, DFF2, Wup_t, kb * 64, n0, 256 * (f / 128) + 128 * bj + (f % 128), scr, lane); continue; } r -= I_UP;
                { const int kb = r / 32, nb = r % 32; p0_transpose_item(args.in[29], DFF, 1024, Wdn_t, kb * 64, nb * 32, nb * 32, scr, lane); }
            }
        }
        for (int m = gw; m < MROWS + 256; m += NGW) {
            const float* src = (m < SEQ) ? x_prompt + (size_t)m * DM : (m < MROWS) ? x_sample + (size_t)(m - SEQ) * DM : mem_prompt + (size_t)(m - MROWS) * DM;
            bf16_t* dst = (m < MROWS) ? XB + (size_t)m * DM : MEMB + (size_t)(m - MROWS) * DM;
#pragma unroll
            for (int j = 0; j < 4; ++j) { const f32x4 v = *((const f32x4*)src + lane + 64 * j); u32x2 w; w.x = cvtpk(v[0], v[1]); w.y = cvtpk(v[2], v[3]); *((u32x2*)dst + lane + 64 * j) = w; }
        }
        {
            const int gt = bx * (NWAVES * 64) + tid, NT = G * NWAVES * 64;
            for (int i = gt; i < 8 * 512 * 128; i += NT) { const int b = i / (512 * 128), rem = i % (512 * 128);
                const f32x4 a = *((const f32x4*)args.in[3] + i), v = *((const f32x4*)args.in[4] + i); u32x2 w;
                w.x = cvtpk(a[0], a[1]); w.y = cvtpk(a[2], a[3]); *(u32x2*)(KAS + (size_t)b * 544 * 512 + (size_t)rem * 4) = w;
                w.x = cvtpk(v[0], v[1]); w.y = cvtpk(v[2], v[3]); *(u32x2*)(VAS + (size_t)b * 544 * 512 + (size_t)rem * 4) = w; }
            for (int i = gt; i < 8 * 1024 * 128; i += NT) { const int b = i / (1024 * 128), rem = i % (1024 * 128);
                const f32x4 a = *((const f32x4*)args.in[5] + i), v = *((const f32x4*)args.in[6] + i); u32x2 w;
                w.x = cvtpk(a[0], a[1]); w.y = cvtpk(a[2], a[3]); *(u32x2*)(KBS + (size_t)b * 1056 * 512 + (size_t)rem * 4) = w;
                w.x = cvtpk(v[0], v[1]); w.y = cvtpk(v[2], v[3]); *(u32x2*)(VBS + (size_t)b * 1056 * 512 + (size_t)rem * 4) = w; }
            for (int i = gt; i < 8 * 256 * 256; i += NT) {
                const f32x4 a = *((const f32x4*)args.in[7] + i), v = *((const f32x4*)args.in[8] + i); u32x2 w;
                w.x = cvtpk(a[0], a[1]); w.y = cvtpk(a[2], a[3]); *(u32x2*)(MKS + (size_t)i * 4) = w;
                w.x = cvtpk(v[0], v[1]); w.y = cvtpk(v[2], v[3]); *(u32x2*)(MVS + (size_t)i * 4) = w; }
            for (int i = gt; i < SEQ * 8; i += NT) { const int pos = i >> 3, j = i & 7;
                const double inv = (j == 0) ? 1.0 : (j == 1) ? 0.19392274474868576 : (j == 2) ? 0.03760603093086393 : (j == 3) ? 0.007292664737217109 : (j == 4) ? 0.001414213562373095 :
                                   (j == 5) ? 0.0002742481756762073 : (j == 6) ? 5.318295896944988e-05 : 1.031338537721246e-05;
                double s, c; sincos_d((double)pos * inv, s, c); ROPE[(size_t)pos * 16 + j] = (float)c; ROPE[(size_t)pos * 16 + 8 + j] = (float)s; }
            for (int i = gt; i < 8 * 640; i += NT) { const int h = i / 640, rel = (i % 640) - 63; const int cl = rel < -128 ? -128 : (rel > 128 ? 128 : rel);
                BT[i] = args.in[11][h * 257 + cl + 128] * LOG2E; }
            if (gt == 0) { float s1 = 0.f, s2 = 0.f; for (int d = 0; d < 64; ++d) { s1 += args.in[12][d] * args.in[13][d]; s2 += args.in[14][d] * args.in[15][d]; }
                LAMP[0] = expf(s1) - expf(s2) + 0.2f; }
        }
    }
    SEAM(0);
    if (IN(1)) REP(1) {
        pg8::Gemm g{XB, Wqkv_t, DM, DM, DM}; pg8::StaticOrder S; S.init(64, 12, G, bx);
        pg8::EpiQKV E{QKVB, out, ROPE, KAS, VAS, KBS, VBS};
        pg8::gemm_phase<pg8::EpiQKV, 0, true, true>(lds, g, S, E);
    }
    SEAM(1);
    if (IN(2)) {
        PHASE_IDS();
      const int xcd = bx & 7, jx = bx >> 3;
      if (jx < TEAM_J0) {
        LAS unsigned char* wl = lds + wave * 8192;
        REP(2) {
            for (int k = 0; k < 5; ++k) {
                const int i = (k & 1) ? (k + 1) * TEAM_J0 - 1 - jx : k * TEAM_J0 + jx;
                if (i >= 128) break;
                const int qb = 63 - (i >> 1), vh = i & 1, hm = xcd;
                attn_body::attn_unit<8>(qb, (const bf16_t*)(ws + WS_QKVB) + 1536 + hm * 64, (const bf16_t*)(ws + WS_QKVB) + 2048 + hm * 64, (const bf16_t*)(ws + WS_QKVB) + 2560 + (hm >> 1) * 128 + vh * 64, NQKV,
                                        (bf16_t*)(ws + WS_OD) + hm * 128 + vh * 64, DM, (char*)lds_raw);
            }
            __syncthreads();
        }
        const int agw = (xcd * TEAM_J0 + jx) * NWAVES + wave, ANW = 8 * TEAM_J0 * NWAVES;
        REP(20) for (int u = agw; u < 4096; u += ANW) {
            const int qblk = u >> 3, h = u & 7, c = qblk >> 1, klo = (64 * c - 512) < 0 ? 0 : (64 * c - 512), nk = 64 * c + 64 - klo;
            gsa_wave<64, true>(QKVB + (size_t)(qblk * 32) * NQKV + h * 64, NQKV, QKVB + (size_t)klo * NQKV + 512 + h * 64, NQKV, QKVB + (size_t)klo * NQKV + 1024 + h * 64, NQKV, nk,
                               BT + h * 640, qblk * 32 - klo + 63, MIXA + (size_t)(qblk * 32) * DM + h * 64, DM, wl, lane);
        }
      } else {
        const int ts = (jx - TEAM_J0) * 8 + xcd, tgw = ts * NWAVES + wave, TNW = TEAM_S * NWAVES;
        unsigned tb = 0;
#define TEAM_BAR() do { ++tb; team_barrier((unsigned*)(ctl + CW_TEAM), (unsigned)TEAM_S * tb); } while (0)
        LAS unsigned char* wl = lds + wave * 8192;
        bf16_t* SQKV = (bf16_t*)(ws + WS_SQKV); bf16_t* SMIXA = (bf16_t*)(ws + WS_SMIXA); bf16_t* SOD = (bf16_t*)(ws + WS_SOD);
        { pg8::Gemm g{XB, Wqkv_t, DM, DM, DM}; pg8::StaticOrder S; S.init(1, 12, TEAM_S, ts, 64);
          pg8::EpiQKV E{SQKV - (size_t)SEQ * NQKV, out, ROPE, KAS, VAS, KBS, VBS};
          pg8::gemm_phase<pg8::EpiQKV, 0, true, true>(lds, g, S, E); }
        { pg8::Gemm g{MEMB, Wmkv_t, DM, DM, DM}; pg8::StaticOrder S; S.init(1, 8, TEAM_S, (ts + TEAM_S - 12) % TEAM_S);
          pg8::EpiMemKV E{out, MKB, MVB, (bf16_t*)(ws + WS_MVT)};
          pg8::gemm_phase<pg8::EpiMemKV, 0, true, true>(lds, g, S, E); }
        TEAM_BAR();
        for (int u = tgw; u < 192; u += TNW) {
            if (u < 64) { const int b = u >> 3, h = u & 7;
                gsa_wave<64, true>(SQKV + (size_t)(b * 32) * NQKV + h * 64, NQKV, KAS + (size_t)b * 544 * 512 + h * 64, 512, VAS + (size_t)b * 544 * 512 + h * 64, 512, 544,
                                   BT + h * 640, 512 + 63, SMIXA + (size_t)(b * 32) * DM + h * 64, DM, wl, lane);
            } else { const int v = u - 64, b = v >> 4, hmv = v & 15, hm = hmv >> 1, vh = hmv & 1;
                gsa_wave<64, false>(SQKV + (size_t)(b * 32) * NQKV + 1536 + hm * 64, NQKV, KBS + (size_t)b * 1056 * 512 + hm * 64, 512, VBS + (size_t)b * 1056 * 512 + (hm >> 1) * 128 + vh * 64, 512, 1056,
                                    nullptr, 0, SOD + (size_t)(b * 32) * DM + hm * 128 + vh * 64, DM, wl, lane);
            }
        }
        TEAM_BAR();
        COMBINE_ROWS(SOD, SMIXA, 0, NSAMP, tgw, TNW);
        TEAM_BAR();
        { pg8::Gemm g{SMIXA - (size_t)SEQ * DM, Wo_t, DM, DM, DM}; pg8::StaticOrder S; S.init(1, 4, TEAM_S, ts, 64);
          pg8::EpiResid E{x_prompt, x_sample, R};
          pg8::gemm_phase<pg8::EpiResid, 0, true, true>(lds, g, S, E); }
        TEAM_BAR();
        LN_PASS(args.in[18], args.in[19], (bf16_t*)(ws + WS_SX1B) - (size_t)SEQ * DM, SEQ, MROWS, tgw, TNW);
        TEAM_BAR();
        { pg8::Gemm g{(bf16_t*)(ws + WS_SX1B) - (size_t)SEQ * DM, Wmq_t, DM, DM, DM}; pg8::StaticOrder S; S.init(1, 4, TEAM_S, ts, 64);
          pg8::EpiBf16S E{(bf16_t*)(ws + WS_SQM) - (size_t)SEQ * DM, DM, C2M};
          pg8::gemm_phase<pg8::EpiBf16S, 0, true, true>(lds, g, S, E); }
        TEAM_BAR();
        for (int u = tgw; u < 128; u += TNW) { const int b = u >> 4, h = (u >> 2) & 3, vc = u & 3;
            gsa_wave<256, false>((bf16_t*)(ws + WS_SQM) + (size_t)(b * 32) * DM + h * 256, DM, MKS + (size_t)b * 256 * 1024 + h * 256, DM, MVS + (size_t)b * 256 * 1024 + h * 256 + vc * 64, DM, 256, nullptr, 0,
                                 (bf16_t*)(ws + WS_SOM) + (size_t)(b * 32) * DM + h * 256 + vc * 64, DM, wl, lane); }
        TEAM_BAR();
        { pg8::Gemm g{(bf16_t*)(ws + WS_SOM) - (size_t)SEQ * DM, Wmo_t, DM, DM, DM}; pg8::StaticOrder S; S.init(1, 4, TEAM_S, ts, 64);
          pg8::EpiResid E{R, R + (size_t)SEQ * DM, R};
          pg8::gemm_phase<pg8::EpiResid, 0, true, true>(lds, g, S, E); }
        TEAM_BAR();
        LN_PASS(args.in[24], args.in[25], (bf16_t*)(ws + WS_SX2B) - (size_t)SEQ * DM, SEQ, MROWS, tgw, TNW);
        TEAM_BAR();
        { pg8::Gemm g{(bf16_t*)(ws + WS_SX2B), Wup_t, DM, DM, DM}; pg8::StaticOrder S; S.init(1, 22, TEAM_S, ts);
          pg8::EpiUpConv<true> E{(bf16_t*)(ws + WS_SH) - (size_t)SEQ * DFF, args.in[27], args.in[28], args.in[9], out + OFF_CVP, out + OFF_CVS};
          pg8::gemm_phase<pg8::EpiUpConv<true>, 0, true, true>(lds, g, S, E); }
        TEAM_BAR();
        { pg8::Gemm g{(bf16_t*)(ws + WS_SH) - (size_t)SEQ * DFF, Wdn_t, DFF, DFF, DFF}; pg8::StaticOrder S; S.init(1, 4, TEAM_S, ts, 64);
          pg8::EpiResid E{R, R + (size_t)SEQ * DM, R};
          pg8::gemm_phase<pg8::EpiResid, 0, true, true>(lds, g, S, E); }
        TEAM_BAR();
        LN_PASS(args.in[30], args.in[31], (bf16_t*)nullptr, SEQ, MROWS, tgw, TNW);
#undef TEAM_BAR
      }
    }
    SEAM(2);
    if (IN(3)) REP(3) { PHASE_IDS(); COMBINE_ROWS(OD, MIXA, 0, SEQ, gw, NGW); }
    SEAM(3);
    if (IN(4)) REP(4) {
        pg8::Gemm g{MIXA, Wo_t, DM, DM, DM}; pg8::StaticOrder S; S.init(64, 4, G, bx);
        pg8::EpiResid E{x_prompt, x_sample, R};
        pg8::gemm_phase<pg8::EpiResid, 0, true, true>(lds, g, S, E);
    }
    SEAM(4);
    if (IN(5)) { PHASE_IDS(); LN_PASS(args.in[18], args.in[19], X1B, 0, SEQ, gw, NGW); }
    SEAM(5);
    if (IN(6)) REP(6) {
        pg8::StaticOrder S; S.init(64, 4, G, bx); pg8::Unit mu;
        if (S.next(0, mu)) {
            { pg8::Gemm g{X1B, Wmq_t, DM, DM, DM}; pg8::EpiBf16S E{QM, DM, C2M};
              pg8::gemm_phase<pg8::EpiBf16S, 0, true, true>(lds, g, S, E); }
            const int h = mu.pn; pg8::StaticOrder S1; S1.init(1, 1, 1, 0, mu.pm);
            { pg8::Gemm g{QM + h * 256, MKB + h * 256, DM, DM, 256}; pg8::EpiSoftmax E{(bf16_t*)(ws + WS_PM) + h * 256, DM, lds + RING_BYTES + 1024};
              pg8::gemm_phase<pg8::EpiSoftmax, 0, true, true>(lds, g, S1, E); }
            { pg8::Gemm g{(bf16_t*)(ws + WS_PM) + h * 256, (bf16_t*)(ws + WS_MVT) + (size_t)h * 256 * 256, DM, 256, 256}; pg8::EpiBf16S E{OM + h * 256, DM, 1.f};
              pg8::gemm_phase<pg8::EpiBf16S, 0, true, true>(lds, g, S1, E); }
        }
    }
    SEAM(6);
    if (IN(8)) {
        pg8::Gemm g{OM, Wmo_t, DM, DM, DM}; pg8::StaticOrder S; S.init(64, 4, G, bx);
        pg8::EpiResid E{R, R + (size_t)SEQ * DM, R};
        pg8::gemm_phase<pg8::EpiResid, 0, true, true>(lds, g, S, E);
    }
    SEAM(8);
    if (IN(9)) {
        PHASE_IDS();
        if (bx == 0) { for (int i = tid; i < 1024; i += NWAVES * 64) ((unsigned*)(ws + WS_X2B - 4096))[i] = 0u; }
        LN_PASS(args.in[24], args.in[25], X2B, 0, SEQ, gw, NGW);
    }
    SEAM(9);
    if (IN(10)) REP(10) {
        { pg8::Gemm g{X2B, Wup_t, DM, DM, DM}; pg8::StaticOrder S; S.init(67, 22, G, bx);
          pg8::EpiUpConv<false> E{HB, args.in[27], args.in[28], args.in[9], out + OFF_CVP, out + OFF_CVS};
          pg8::gemm_phase<pg8::EpiUpConv<false>, 1, true, true>(lds, g, S, E); }
    }
    SEAM(10);
    if (IN(11)) {
        pg8::Gemm g{HB, Wdn_t, DFF, DFF, DFF}; pg8::StaticOrder S; S.init(64, 4, G, bx);
        pg8::EpiResid E{R, R + (size_t)SEQ * DM, R};
        pg8::gemm_phase<pg8::EpiResid, 0, true, true>(lds, g, S, E);
    }
    SEAM(11);
    if (IN(12)) { PHASE_IDS(); LN_PASS(args.in[30], args.in[31], (bf16_t*)nullptr, 0, SEQ, gw, NGW); }
#undef IN
#undef SEAM
}

extern "C" void kernel_launch(void* const* d_in, const int* in_sizes, int n_in, void* d_out, int out_size, void* d_ws, size_t ws_size, hipStream_t stream) {
    static int grid = 0;
    if (grid == 0) {
        int dev = 0, cus = 0;
        if (hipGetDevice(&dev) != hipSuccess || hipDeviceGetAttribute(&cus, hipDeviceAttributeMultiprocessorCount, dev) != hipSuccess) { fprintf(stderr, "kernel_launch: device query failed\n"); grid = -1; return; }
        if (hipFuncSetAttribute((const void*)mk_fwd, hipFuncAttributeMaxDynamicSharedMemorySize, LDS_BYTES) != hipSuccess) { fprintf(stderr, "kernel_launch: hipFuncSetAttribute failed\n"); grid = -1; return; }
        int per_cu = 0;
        if (hipOccupancyMaxActiveBlocksPerMultiprocessor(&per_cu, (const void*)mk_fwd, NWAVES * 64, LDS_BYTES) != hipSuccess || per_cu < 1) fprintf(stderr, "kernel_launch: occupancy query reports %d\n", per_cu);
        (void)hipGetLastError();
        grid = cus;
        fprintf(stderr, "kernel_launch: grid %d, ws %zu, n_in %d, out %d\n", grid, ws_size, n_in, out_size);
    }
    if (grid < 0) return;
    (void)hipMemsetAsync((char*)d_ws + WS_CTL, 0, CTL_ZERO_BYTES, stream);
    Args a{};
    for (int i = 0; i < 32; ++i) a.in[i] = (const float*)d_in[i];
    a.out = (float*)d_out; a.ws = (unsigned char*)d_ws;
    if (N_LAUNCHES == 1) { a.ph_lo = 0; a.ph_hi = NPHASE; a.li = 0; hipLaunchKernelGGL(mk_fwd, dim3(grid), dim3(NWAVES * 64), LDS_BYTES, stream, a); }
    else for (int li = 0; li < NPHASE; ++li) { a.ph_lo = li; a.ph_hi = li + 1; a.li = li; hipLaunchKernelGGL(mk_fwd, dim3(grid), dim3(NWAVES * 64), LDS_BYTES, stream, a); }
}
```
